# Optimizing an MI355X kernel written in HIP

```python
import math
import jax, jax.numpy as jnp
from jax import lax
import numpy as np

D_MODEL = 1024
BATCH = 4
SEQ = 8192
DEPTH = 1

PLE_DIM = 256
CHUNK = 128
A_GROUPS = 8
A_GROUP_DIM = D_MODEL // A_GROUPS
A_WIDTH = A_GROUPS * A_GROUP_DIM
B_HEADS = 8
B_QK_DIM = 64
B_V_DIM = 2 * B_QK_DIM
B_QK_WIDTH = B_HEADS * 2 * B_QK_DIM
B_WIDTH = B_HEADS * B_V_DIM
Q_BLOCK = 128
ROPE_THETA = 10000.0
LN_EPS = 1e-5
RMS_EPS = 1e-5
DEEPNORM_ALPHA = (2 * DEPTH) ** 0.25
DEEPNORM_BETA = (8 * DEPTH) ** -0.25
IN_SIZES = (A_WIDTH, A_WIDTH, A_WIDTH, B_QK_WIDTH, B_QK_WIDTH, B_WIDTH, B_WIDTH, D_MODEL, D_MODEL)
IN_WIDTH = sum(IN_SIZES)
IN_OFFSETS = tuple(int(o) for o in np.cumsum(IN_SIZES)[:-1])
B_V_OFFSET = 3 * A_WIDTH + 2 * B_QK_WIDTH

kernel_name = "hybrid_gmlp_diffattn_gated_deepnorm"


def layer_norm(x, g, b):
    xf = x.astype(jnp.float32)
    mu = jnp.mean(xf, axis=-1, keepdims=True)
    xc = xf - mu
    var = jnp.mean(xc * xc, axis=-1, keepdims=True)
    y = xc * lax.rsqrt(var + LN_EPS) * g.astype(jnp.float32) + b.astype(jnp.float32)
    return y.astype(x.dtype)


def rms_norm(x, g):
    xf = x.astype(jnp.float32)
    y = xf * lax.rsqrt(jnp.mean(xf * xf, axis=-1, keepdims=True) + RMS_EPS) * g.astype(jnp.float32)
    return y.astype(x.dtype)


def rope_tables(positions, dim):
    inv_freq = ROPE_THETA ** (-jnp.arange(0, dim, 2, dtype=jnp.float32) / dim)
    ang = positions.astype(jnp.float32)[..., None] * inv_freq
    return jnp.cos(ang), jnp.sin(ang)


def apply_rope(t, cos, sin):
    c = cos[:, :, None, None, :].astype(t.dtype)
    s = sin[:, :, None, None, :].astype(t.dtype)
    t1, t2 = jnp.split(t, 2, axis=-1)
    return jnp.concatenate([t1 * c - t2 * s, t2 * c + t1 * s], axis=-1)


def diff_attention(q, k, v, lam):
    bn, s_len = q.shape[0], q.shape[1]
    nb = s_len // Q_BLOCK
    qb = q.reshape(bn, nb, Q_BLOCK, B_HEADS, 2, B_QK_DIM).transpose(1, 0, 2, 3, 4, 5)
    starts = jnp.arange(nb, dtype=jnp.int32) * Q_BLOCK
    kpos = jnp.arange(s_len, dtype=jnp.int32)

    def block(args):
        qblk, start = args
        qpos = start + jnp.arange(Q_BLOCK, dtype=jnp.int32)
        mask = kpos[None, :] <= qpos[:, None]
        sc = jnp.einsum("bqhmd,bkhmd->bhmqk", qblk, k,
                        preferred_element_type=jnp.float32)
        sc = jnp.where(mask, sc, -jnp.inf)
        pr = jax.nn.softmax(sc, axis=-1)
        a = pr[:, :, 0] - lam * pr[:, :, 1]
        return jnp.einsum("bhqk,bkhd->bqhd", a.astype(v.dtype), v)

    o = lax.map(block, (qb, starts))
    return o.transpose(1, 0, 2, 3, 4).reshape(bn, s_len, B_HEADS, B_V_DIM)


def setup_inputs(seed: int = 0) -> dict:
    key = jax.random.key(seed)
    ks = jax.random.split(key, 24)
    f32 = jnp.float32
    nrm = lambda k, shape, scale: jax.random.normal(k, shape, f32) * scale
    x = nrm(ks[0], (BATCH, SEQ, D_MODEL), 1.0)
    p = nrm(ks[1], (DEPTH, BATCH, SEQ, PLE_DIM), 1.0)
    offset = jax.random.randint(ks[2], (BATCH, 1), 0, 1024, dtype=jnp.int32)
    positions = offset + jnp.arange(SEQ, dtype=jnp.int32)[None, :]
    w_in = nrm(ks[3], (DEPTH, D_MODEL, IN_WIDTH), D_MODEL ** -0.5)
    w_in = w_in.at[:, :, B_V_OFFSET:B_V_OFFSET + B_WIDTH].multiply(DEEPNORM_BETA)
    a_ln_g = 1.0 + nrm(ks[4], (DEPTH, A_WIDTH), 0.05)
    a_ln_b = nrm(ks[5], (DEPTH, A_WIDTH), 0.02)
    a_w_s = nrm(ks[6], (DEPTH, A_GROUPS, CHUNK, CHUNK), CHUNK ** -0.5)
    a_b_s = 1.0 + nrm(ks[7], (DEPTH, A_GROUPS, CHUNK), 0.1)
    b_lam_q1 = nrm(ks[8], (DEPTH, B_QK_DIM), 0.1)
    b_lam_k1 = nrm(ks[9], (DEPTH, B_QK_DIM), 0.1)
    b_lam_q2 = nrm(ks[10], (DEPTH, B_QK_DIM), 0.1)
    b_lam_k2 = nrm(ks[11], (DEPTH, B_QK_DIM), 0.1)
    b_subln_g = 1.0 + nrm(ks[12], (DEPTH, B_V_DIM), 0.05)
    w_branch_a = nrm(ks[13], (DEPTH, A_WIDTH, D_MODEL), A_WIDTH ** -0.5 * DEEPNORM_BETA)
    w_branch_b = nrm(ks[14], (DEPTH, B_WIDTH, D_MODEL), B_WIDTH ** -0.5 * DEEPNORM_BETA)
    w_out = nrm(ks[15], (DEPTH, D_MODEL, D_MODEL), D_MODEL ** -0.5 * DEEPNORM_BETA)
    w_ple = nrm(ks[16], (DEPTH, PLE_DIM, D_MODEL), PLE_DIM ** -0.5 * DEEPNORM_BETA)
    w_ple_gate = nrm(ks[17], (DEPTH, D_MODEL, D_MODEL), D_MODEL ** -0.5)
    ln_g = 1.0 + nrm(ks[18], (DEPTH, D_MODEL), 0.05)
    ln_b = nrm(ks[19], (DEPTH, D_MODEL), 0.02)
    return {"x": x, "p": p, "positions": positions, "w_in": w_in,
            "a_ln_g": a_ln_g, "a_ln_b": a_ln_b, "a_w_s": a_w_s, "a_b_s": a_b_s,
            "b_lam_q1": b_lam_q1, "b_lam_k1": b_lam_k1, "b_lam_q2": b_lam_q2, "b_lam_k2": b_lam_k2,
            "b_subln_g": b_subln_g, "w_branch_a": w_branch_a, "w_branch_b": w_branch_b,
            "w_out": w_out, "w_ple": w_ple, "w_ple_gate": w_ple_gate,
            "ln_g": ln_g, "ln_b": ln_b}


def reference(x, p, positions, w_in, a_ln_g, a_ln_b, a_w_s, a_b_s,
              b_lam_q1, b_lam_k1, b_lam_q2, b_lam_k2, b_subln_g,
              w_branch_a, w_branch_b, w_out, w_ple, w_ple_gate, ln_g, ln_b):
    bn, s_len, _ = x.shape
    n_chunks = s_len // CHUNK
    cos, sin = rope_tables(positions, B_QK_DIM)
    causal_chunk = jnp.tril(jnp.ones((CHUNK, CHUNK), dtype=bool))
    for i in range(DEPTH):
        lam_init = 0.8 - 0.6 * math.exp(-0.3 * i)
        h = x @ w_in[i]
        ua, va, za, qh, kh, vh, zb, ga, gb = jnp.split(h, IN_OFFSETS, axis=-1)

        ua = jax.nn.gelu(ua, approximate=False)
        va = layer_norm(jax.nn.gelu(va, approximate=False), a_ln_g[i], a_ln_b[i])
        vc = va.reshape(bn, n_chunks, CHUNK, A_GROUPS, A_GROUP_DIM)
        ws = jnp.where(causal_chunk, a_w_s[i], 0.0)
        sa = jnp.einsum("gts,bnsgc->bntgc", ws, vc) + a_b_s[i].T[:, :, None]
        ya = ua * sa.reshape(bn, s_len, A_WIDTH) * jax.nn.silu(za)

        q = apply_rope(qh.reshape(bn, s_len, B_HEADS, 2, B_QK_DIM), cos, sin) * (B_QK_DIM ** -0.5)
        k = apply_rope(kh.reshape(bn, s_len, B_HEADS, 2, B_QK_DIM), cos, sin)
        lam = (jnp.exp(jnp.sum(b_lam_q1[i].astype(jnp.float32) * b_lam_k1[i].astype(jnp.float32)))
               - jnp.exp(jnp.sum(b_lam_q2[i].astype(jnp.float32) * b_lam_k2[i].astype(jnp.float32)))
               + lam_init)
        o = diff_attention(q, k, vh.reshape(bn, s_len, B_HEADS, B_V_DIM), lam)
        o = rms_norm(o, b_subln_g[i]) * (1.0 - lam_init)
        yb = o.reshape(bn, s_len, B_WIDTH) * jax.nn.silu(zb)

        merged = jax.nn.sigmoid(ga) * (ya @ w_branch_a[i]) + jax.nn.sigmoid(gb) * (yb @ w_branch_b[i])
        mix_out = merged @ w_out[i]

        ple = jax.nn.sigmoid(x @ w_ple_gate[i]) * (p[i] @ w_ple[i])

        x = layer_norm(DEEPNORM_ALPHA * x + mix_out + ple, ln_g[i], ln_b[i])
    return x
```

```cpp
#include <hip/hip_runtime.h>
#include <cstdio>
#include <cstdint>
#include <cmath>

typedef unsigned short bf16_t;
constexpr int BATCH = 4, SEQ = 8192, DM = 1024, M = BATCH * SEQ, PLE = 256, INW = 9216;
constexpr float LN_EPS = 1e-5f, RMS_EPS = 1e-5f;
constexpr float ALPHA = 1.189207115002721f;
constexpr float LAM_INIT = 0.2f;

constexpr size_t MiB = 1u << 20;
constexpr size_t WS_CTL = 0, WS_W1T = 1 * MiB, WS_WAT = 21 * MiB, WS_WBT = 23 * MiB, WS_WOT = 25 * MiB, WS_WPLT = 27 * MiB, WS_WSF = 27 * MiB + 512 * 1024;
constexpr size_t WS_COS = 28 * MiB, WS_SIN = 32 * MiB, WS_STATS = 36 * MiB, WS_PB = 40 * MiB, WS_XB = 56 * MiB;
constexpr size_t WS_SEG0 = 120 * MiB, WS_SEG1 = 184 * MiB, WS_SEG2 = 248 * MiB, WS_SEG3 = 312 * MiB, WS_SEG4 = 376 * MiB, WS_SEG5 = 440 * MiB, WS_END = 504 * MiB;

__device__ __forceinline__ float bf2f(bf16_t v) { return __uint_as_float(((unsigned)v) << 16); }
__device__ __forceinline__ bf16_t f2bf(float f) { unsigned u = __float_as_uint(f); return (bf16_t)((u + 0x7fffu + ((u >> 16) & 1u)) >> 16); }
__device__ __forceinline__ float gelu_exact(float v) { return 0.5f * v * (1.0f + erff(v * 0.70710678118654752f)); }
__device__ __forceinline__ float sigmoidf_(float v) { return 1.0f / (1.0f + expf(-v)); }
__device__ __forceinline__ float wave_sum(float v) {
#pragma unroll
    for (int o = 1; o < 64; o <<= 1) v += __shfl_xor(v, o);
    return v;
}
__device__ __forceinline__ float wave_max(float v) {
#pragma unroll
    for (int o = 1; o < 64; o <<= 1) v = fmaxf(v, __shfl_xor(v, o));
    return v;
}

struct InvFreq { float f[32]; };

__global__ void k_rope_table(const int* pos, InvFreq inv, float* cosT, float* sinT) {
    const int idx = blockIdx.x * blockDim.x + threadIdx.x;
    if (idx >= M * 32) return;
    const int m = idx >> 5, i = idx & 31;
    const float ang = (float)pos[m] * inv.f[i];
    cosT[idx] = cosf(ang); sinT[idx] = sinf(ang);
}

struct NEpi {
    int act;
    float scale;
    const float* cosT; const float* sinT;
    const bf16_t* gate;
    const bf16_t* addb;
    const float* addf; float addf_scale;
    bf16_t* outb; float* outf;
};
template <int AT>
__global__ void __launch_bounds__(256) k_ngemm(const void* Av, int lda, const float* B, int ldb, int K, NEpi e) {
    __shared__ float As[16][65];
    __shared__ float Bs[16][64];
    const int tid = threadIdx.x, tx = tid & 15, ty = tid >> 4;
    const int row0 = blockIdx.y * 64, col0 = blockIdx.x * 64;
    float acc[4][4] = {};
    for (int k0 = 0; k0 < K; k0 += 16) {
        for (int i = tid; i < 64 * 16; i += 256) {
            const int r = i >> 4, kk = i & 15; float v;
            if (AT == 0) v = ((const float*)Av)[(size_t)(row0 + r) * lda + k0 + kk];
            else v = bf2f(((const bf16_t*)Av)[(size_t)(row0 + r) * lda + k0 + kk]);
            As[kk][r] = v;
        }
        for (int i = tid; i < 16 * 64; i += 256) { const int kk = i >> 6, c = i & 63; Bs[kk][c] = B[(size_t)(k0 + kk) * ldb + col0 + c]; }
        __syncthreads();
#pragma unroll
        for (int kk = 0; kk < 16; ++kk) {
            float a[4], b[4];
#pragma unroll
            for (int i = 0; i < 4; ++i) { a[i] = As[kk][ty + 16 * i]; b[i] = Bs[kk][tx + 16 * i]; }
#pragma unroll
            for (int i = 0; i < 4; ++i)
#pragma unroll
                for (int j = 0; j < 4; ++j) acc[i][j] = fmaf(a[i], b[j], acc[i][j]);
        }
        __syncthreads();
    }
#pragma unroll
    for (int i = 0; i < 4; ++i) {
        const int row = row0 + ty + 16 * i;
        float v[4];
#pragma unroll
        for (int j = 0; j < 4; ++j) v[j] = acc[i][j];
        if (e.act == 1) { for (int j = 0; j < 4; ++j) v[j] = gelu_exact(v[j]); }
        else if (e.act == 2) { for (int j = 0; j < 4; ++j) v[j] = v[j] * sigmoidf_(v[j]); }
        else if (e.act == 3) { for (int j = 0; j < 4; ++j) v[j] = sigmoidf_(v[j]); }
        else if (e.act == 4) {
            for (int j = 0; j < 2; ++j) {
                const int fi = (tx + 16 * j) & 31;
                const float c = e.cosT[(size_t)row * 32 + fi], s = e.sinT[(size_t)row * 32 + fi];
                const float t1 = v[j], t2 = v[j + 2];
                v[j] = (t1 * c - t2 * s) * e.scale; v[j + 2] = (t2 * c + t1 * s) * e.scale;
            }
        }
#pragma unroll
        for (int j = 0; j < 4; ++j) {
            const size_t idx = (size_t)row * 1024 + col0 + tx + 16 * j;
            float o = v[j];
            if (e.gate) o *= bf2f(e.gate[idx]);
            if (e.addb) o += bf2f(e.addb[idx]);
            if (e.addf) o += e.addf_scale * e.addf[idx];
            if (e.outb) e.outb[idx] = f2bf(o); else e.outf[idx] = o;
        }
    }
}

__global__ void __launch_bounds__(256) k_stats(const bf16_t* VA, float2* stats) {
    const int row = blockIdx.x * 4 + (threadIdx.x >> 6), lane = threadIdx.x & 63;
    float s = 0.f, ss = 0.f;
    for (int c = lane; c < 1024; c += 64) { const float v = bf2f(VA[(size_t)row * 1024 + c]); s += v; ss += v * v; }
    s = wave_sum(s); ss = wave_sum(ss);
    if (lane < 16) stats[(size_t)row * 16 + lane] = lane == 0 ? make_float2(s, ss) : make_float2(0.f, 0.f);
}

__global__ void __launch_bounds__(128) k_brancha(bf16_t* UA, const bf16_t* VA, const bf16_t* ZA, const float2* stats,
                                                 const float* ln_g, const float* ln_b, const float* w_s, const float* b_s) {
    __shared__ bf16_t vn[128 * 128];
    __shared__ float mu[128], rs[128];
    const int chunk = blockIdx.x >> 3, g = blockIdx.x & 7, c = threadIdx.x;
    const int tok0 = chunk * 128;
    {
        const int s = threadIdx.x; float a = 0.f, b = 0.f;
        for (int p = 0; p < 16; ++p) { const float2 v = stats[(size_t)(tok0 + s) * 16 + p]; a += v.x; b += v.y; }
        const float m_ = a * (1.f / 1024.f); const float var = b * (1.f / 1024.f) - m_ * m_;
        mu[s] = m_; rs[s] = rsqrtf(var + LN_EPS);
    }
    __syncthreads();
    const float gg = ln_g[g * 128 + c], bb = ln_b[g * 128 + c];
    for (int s = 0; s < 128; ++s) {
        const float v = bf2f(VA[(size_t)(tok0 + s) * 1024 + g * 128 + c]);
        vn[s * 128 + c] = f2bf((v - mu[s]) * rs[s] * gg + bb);
    }
    __syncthreads();
    const float* ws = w_s + (size_t)g * 128 * 128;
    for (int t = 0; t < 128; ++t) {
        float acc = 0.f;
        for (int s = 0; s <= t; ++s) acc = fmaf(ws[t * 128 + s], bf2f(vn[s * 128 + c]), acc);
        acc += b_s[g * 128 + t];
        const size_t idx = (size_t)(tok0 + t) * 1024 + g * 128 + c;
        UA[idx] = f2bf(bf2f(UA[idx]) * acc * bf2f(ZA[idx]));
    }
}

__global__ void __launch_bounds__(256) k_attn(const bf16_t* Q, const bf16_t* Kb, const bf16_t* V, bf16_t* ZB,
                                              const float* lq1, const float* lk1, const float* lq2, const float* lk2, const float* subg) {
    __shared__ float qs[4][128];
    const int w = threadIdx.x >> 6, lane = threadIdx.x & 63;
    const int gid = blockIdx.x * 4 + w;
    const int h = gid & 7, tokq = gid >> 3;
    const int b = tokq / SEQ, qpos = tokq - b * SEQ;
    float lam;
    { const float a = wave_sum(lq1[lane] * lk1[lane]), c = wave_sum(lq2[lane] * lk2[lane]); lam = expf(a) - expf(c) + LAM_INIT; }
    qs[w][lane] = bf2f(Q[(size_t)tokq * 1024 + h * 128 + lane]);
    qs[w][64 + lane] = bf2f(Q[(size_t)tokq * 1024 + h * 128 + 64 + lane]);
    __syncthreads();
    float m0 = -1e30f, m1 = -1e30f, l0 = 0.f, l1 = 0.f;
    float a00 = 0.f, a01 = 0.f, a10 = 0.f, a11 = 0.f;
    const size_t rb = (size_t)b * SEQ;
    for (int kc = 0; kc <= qpos / 64; ++kc) {
        const int j = kc * 64 + lane; const bool valid = j <= qpos;
        float s0 = 0.f, s1 = 0.f;
        const bf16_t* kr = Kb + (rb + j) * 1024 + h * 128;
        for (int d8 = 0; d8 < 8; ++d8) {
            const uint4 u0 = *(const uint4*)(kr + d8 * 8), u1 = *(const uint4*)(kr + 64 + d8 * 8);
            const unsigned a0[4] = {u0.x, u0.y, u0.z, u0.w}, a1[4] = {u1.x, u1.y, u1.z, u1.w};
            for (int e2 = 0; e2 < 4; ++e2) {
                s0 = fmaf(qs[w][d8 * 8 + 2 * e2], __uint_as_float(a0[e2] << 16), s0); s0 = fmaf(qs[w][d8 * 8 + 2 * e2 + 1], __uint_as_float(a0[e2] & 0xffff0000u), s0);
                s1 = fmaf(qs[w][64 + d8 * 8 + 2 * e2], __uint_as_float(a1[e2] << 16), s1); s1 = fmaf(qs[w][64 + d8 * 8 + 2 * e2 + 1], __uint_as_float(a1[e2] & 0xffff0000u), s1);
            }
        }
        if (!valid) { s0 = -INFINITY; s1 = -INFINITY; }
        const float n0 = fmaxf(m0, wave_max(s0)), n1 = fmaxf(m1, wave_max(s1));
        const float p0 = valid ? expf(s0 - n0) : 0.f, p1 = valid ? expf(s1 - n1) : 0.f;
        const float f0 = expf(m0 - n0), f1 = expf(m1 - n1);
        l0 = l0 * f0 + wave_sum(p0); l1 = l1 * f1 + wave_sum(p1);
        a00 *= f0; a01 *= f0; a10 *= f1; a11 *= f1; m0 = n0; m1 = n1;
        const int nk = min(64, qpos - kc * 64 + 1);
        for (int jj = 0; jj < nk; ++jj) {
            const float pj0 = __shfl(p0, jj), pj1 = __shfl(p1, jj);
            const unsigned vv = *(const unsigned*)(V + (rb + kc * 64 + jj) * 1024 + h * 128 + 2 * lane);
            const float v0 = bf2f((bf16_t)(vv & 0xffff)), v1 = bf2f((bf16_t)(vv >> 16));
            a00 = fmaf(pj0, v0, a00); a01 = fmaf(pj0, v1, a01); a10 = fmaf(pj1, v0, a10); a11 = fmaf(pj1, v1, a11);
        }
    }
    float o0 = a00 / l0 - lam * a10 / l1, o1 = a01 / l0 - lam * a11 / l1;
    const float ss = wave_sum(o0 * o0 + o1 * o1) * (1.f / 128.f);
    const float r = rsqrtf(ss + RMS_EPS) * (1.f - LAM_INIT);
    const size_t idx = (size_t)tokq * 1024 + h * 128 + 2 * lane;
    o0 = o0 * r * subg[2 * lane] * bf2f(ZB[idx]); o1 = o1 * r * subg[2 * lane + 1] * bf2f(ZB[idx + 1]);
    ZB[idx] = f2bf(o0); ZB[idx + 1] = f2bf(o1);
}

__global__ void __launch_bounds__(256) k_ln_final(float* Y, const float* g, const float* bta) {
    const int row = blockIdx.x * 4 + (threadIdx.x >> 6), lane = threadIdx.x & 63;
    float v[16]; float s = 0.f;
    for (int i = 0; i < 16; ++i) { v[i] = Y[(size_t)row * 1024 + lane + 64 * i]; s += v[i]; }
    const float mean = wave_sum(s) * (1.f / 1024.f); float q = 0.f;
    for (int i = 0; i < 16; ++i) { v[i] -= mean; q += v[i] * v[i]; }
    const float rstd = rsqrtf(wave_sum(q) * (1.f / 1024.f) + LN_EPS);
    for (int i = 0; i < 16; ++i) { const int c = lane + 64 * i; Y[(size_t)row * 1024 + c] = v[i] * rstd * g[c] + bta[c]; }
}

extern "C" void kernel_launch(void* const* d_in, const int* in_sizes, int n_in, void* d_out, int out_size, void* d_ws, size_t ws_size, hipStream_t stream) {
    if (n_in != 20 || in_sizes[0] != M * DM || out_size != M * DM || ws_size < WS_END) {
        fprintf(stderr, "kernel_launch: unexpected shapes n_in %d in0 %d out %d ws %zu (need %zu)\n", n_in, n_in > 0 ? in_sizes[0] : -1, out_size, ws_size, (size_t)WS_END);
        return;
    }
    const float* x = (const float*)d_in[0]; const float* p = (const float*)d_in[1]; const int* pos = (const int*)d_in[2];
    const float* w_in = (const float*)d_in[3]; const float* a_ln_g = (const float*)d_in[4]; const float* a_ln_b = (const float*)d_in[5];
    const float* a_w_s = (const float*)d_in[6]; const float* a_b_s = (const float*)d_in[7];
    const float* lq1 = (const float*)d_in[8]; const float* lk1 = (const float*)d_in[9]; const float* lq2 = (const float*)d_in[10]; const float* lk2 = (const float*)d_in[11];
    const float* subg = (const float*)d_in[12]; const float* w_a = (const float*)d_in[13]; const float* w_b = (const float*)d_in[14];
    const float* w_out = (const float*)d_in[15]; const float* w_ple = (const float*)d_in[16]; const float* w_pg = (const float*)d_in[17];
    const float* ln_g = (const float*)d_in[18]; const float* ln_b = (const float*)d_in[19];
    unsigned char* ws = (unsigned char*)d_ws; float* out = (float*)d_out;
    float* cosT = (float*)(ws + WS_COS); float* sinT = (float*)(ws + WS_SIN); float2* stats = (float2*)(ws + WS_STATS);
    bf16_t* SEG0 = (bf16_t*)(ws + WS_SEG0); bf16_t* SEG1 = (bf16_t*)(ws + WS_SEG1); bf16_t* SEG2 = (bf16_t*)(ws + WS_SEG2);
    bf16_t* SEG3 = (bf16_t*)(ws + WS_SEG3); bf16_t* SEG4 = (bf16_t*)(ws + WS_SEG4); bf16_t* SEG5 = (bf16_t*)(ws + WS_SEG5);
    bf16_t* GA = (bf16_t*)d_out; bf16_t* GB = GA + (size_t)M * 1024;

    InvFreq inv; for (int i = 0; i < 32; ++i) inv.f[i] = (float)std::pow(10000.0, -(double)i / 32.0);
    k_rope_table<<<M * 32 / 256, 256, 0, stream>>>(pos, inv, cosT, sinT);

    const dim3 g1(16, M / 64);
    auto seg = [&](int s, int act, bf16_t* dst, float scale) {
        NEpi e{}; e.act = act; e.scale = scale; e.cosT = cosT; e.sinT = sinT; e.outb = dst;
        const float* B = s < 9 ? w_in + s * 1024 : w_pg; const int ldb = s < 9 ? INW : 1024;
        k_ngemm<0><<<g1, 256, 0, stream>>>(x, DM, B, ldb, DM, e);
    };
    seg(0, 1, SEG0, 1.f); seg(1, 1, SEG1, 1.f); seg(2, 2, SEG2, 1.f);
    k_stats<<<M / 4, 256, 0, stream>>>(SEG1, stats);
    k_brancha<<<(M / 128) * 8, 128, 0, stream>>>(SEG0, SEG1, SEG2, stats, a_ln_g, a_ln_b, a_w_s, a_b_s);
    seg(3, 4, SEG1, 0.125f); seg(4, 4, SEG2, 1.f); seg(5, 0, SEG3, 1.f);
    seg(6, 2, SEG4, 1.f); seg(7, 3, GA, 1.f); seg(8, 3, GB, 1.f); seg(9, 3, SEG5, 1.f);
    k_attn<<<M * 8 / 4, 256, 0, stream>>>(SEG1, SEG2, SEG3, SEG4, lq1, lk1, lq2, lk2, subg);
    { NEpi e{}; e.gate = GA; e.outb = SEG1; k_ngemm<1><<<g1, 256, 0, stream>>>(SEG0, 1024, w_a, 1024, 1024, e); }
    { NEpi e{}; e.gate = GB; e.addb = SEG1; e.outb = SEG1; k_ngemm<1><<<g1, 256, 0, stream>>>(SEG4, 1024, w_b, 1024, 1024, e); }
    { NEpi e{}; e.gate = SEG5; e.addf = x; e.addf_scale = ALPHA; e.outf = out; k_ngemm<0><<<g1, 256, 0, stream>>>(p, PLE, w_ple, 1024, PLE, e); }
    { NEpi e{}; e.addf = out; e.addf_scale = 1.f; e.outf = out; k_ngemm<1><<<g1, 256, 0, stream>>>(SEG1, 1024, w_out, 1024, 1024, e); }
    k_ln_final<<<M / 4, 256, 0, stream>>>(out, ln_g, ln_b);
}
```

```cpp
#include <hip/hip_runtime.h>
#include <cstdio>
#include <cstdint>
#include <cmath>
namespace pg8 {
#define PG8_LAS __attribute__((address_space(3)))
typedef unsigned short bf16_t;
typedef short bf16x8 __attribute__((ext_vector_type(8)));
typedef float f32x4 __attribute__((ext_vector_type(4)));
typedef unsigned u32x4 __attribute__((ext_vector_type(4)));
constexpr int BM = 256, BK = 64, HALF = 128, HTB = HALF * BK * 2  , STAGE_BYTES = 8 * HTB, NXCD = 8, WGM = 8;

__host__ __device__ __forceinline__ int lds_byte(int r, int c) { const int st = (r >> 4) * 2 + (c >> 5), rr = r & 15, cc = c & 31, ob = rr * 64 + cc * 2; return st * 1024 + (ob ^ (((ob >> 9) & 1) << 5)); }
__host__ __device__ __forceinline__ void stage_rc(int b, int& R, int& C) { const int st = b / 1024, sb = b % 1024, swz = sb ^ (((sb >> 9) & 1) << 5); R = (st >> 1) * 16 + swz / 64; C = (st & 1) * 32 + (swz % 64) / 2; }
__host__ __device__ __forceinline__ int perm32(int rho) { const int n = rho >> 4, i = rho & 15; return 8 * (i >> 2) + 4 * n + (i & 3); }

struct Unit { int pm, pn; };
struct Gemm { const bf16_t* A; const bf16_t* Bt; int M, N, K; };

struct StaticOrder {
    int nM, nN, nwg, G, c;
    __host__ __device__ void init(int M, int N, int G_, int c_) { nM = M / BM; nN = N / BM; nwg = nM * nN; G = G_; c = c_; }
    __host__ __device__ bool next(int i, Unit& u) const {
        const long L = (long)i * G + c; if (L >= nwg) return false;
        int wgid = (int)L; { const int q = nwg / NXCD, r = nwg % NXCD, xcd = wgid % NXCD, off = wgid / NXCD; wgid = (xcd < r ? xcd * (q + 1) : r * (q + 1) + (xcd - r) * q) + off; }
        const int nig = WGM * nN, gid = wgid / nig, fm = gid * WGM, gsz = (nM - fm) < WGM ? (nM - fm) : WGM;
        u.pm = fm + ((wgid % nig) % gsz); u.pn = (wgid % nig) / gsz; return true;
    }
    __device__ __forceinline__ void a_ready(const Unit&) const {}
    __device__ __forceinline__ void done(const Unit&) const {}
};
typedef float f32x2_cv __attribute__((ext_vector_type(2))); typedef __bf16 bf16x2_cv __attribute__((ext_vector_type(2)));
__device__ __forceinline__ unsigned cvt_pk_bf16(float lo, float hi) { f32x2_cv v = {lo, hi}; bf16x2_cv b = __builtin_convertvector(v, bf16x2_cv); return __builtin_bit_cast(unsigned, b); }
typedef float f32x2 __attribute__((ext_vector_type(2)));
__device__ __forceinline__ f32x2 gelu_pk(f32x2 v) {
    const f32x2 av = __builtin_elementwise_abs(v), d = av * 0.2316418882f + 1.0f;
    f32x2 t; t.x = __builtin_amdgcn_rcpf(d.x); t.y = __builtin_amdgcn_rcpf(d.y);
    f32x2 q = t * 0.5307027145f + (-0.7265760135f); q = q * t + 0.7107068705f; q = q * t + (-0.142248368f); q = q * t + 0.127414796f; q = q * t;
    const f32x2 s = (v * v) * (-0.72134752044f);
    f32x2 e; e.x = __builtin_amdgcn_exp2f(s.x); e.y = __builtin_amdgcn_exp2f(s.y);
    const f32x2 m = v * (q * e), r = v - m;
    f32x2 o; o.x = v.x < 0.f ? m.x : r.x; o.y = v.y < 0.f ? m.y : r.y; return o;
}
template <class Epi, class Sched, bool ALIGN_EPI = false, bool SP2 = false>
__device__ __forceinline__ void gemm_phase(PG8_LAS unsigned char* lds, const Gemm g, const Sched& S, const Epi& E) {
    int tid_ = threadIdx.x; asm volatile("" : "+v"(tid_));
    const int tid = tid_, wid = __builtin_amdgcn_readfirstlane(tid >> 6), lane = tid & 63, wr = wid >> 2, wc = wid & 3, fr = lane & 15, fq = lane >> 4;
    const int K = g.K, nt = K / BK;
    unsigned voffA[2], voffB[2];
#pragma unroll
    for (int i = 0; i < 2; ++i) { int R, C; stage_rc(tid * 16 + i * 8192, R, C); const int Rb = Epi::PERM ? ((R & ~31) + perm32(R & 31)) : R;
        voffA[i] = (unsigned)(R * K + C) * 2u; voffB[i] = (unsigned)(Rb * K + C) * 2u; }
    const size_t kstep = (size_t)(BK * 2);
    const size_t hstep = (size_t)HALF * K * 2;
    const size_t tstep = 2 * hstep;
    const unsigned ldsw = (unsigned)wid * 1024u;
    const int aoff = lds_byte(wr * 64 + fr, fq * 8), boff = lds_byte(wc * 32 + fr, fq * 8);
#define PG8_SA(b, h) (((b) * 2 + (h)) * HTB)
#define PG8_SB(b, h) ((4 + (b) * 2 + (h)) * HTB)
#define PG8_STAGE(bufoff, gbase, voff) do { _Pragma("unroll") for (int _i = 0; _i < 2; ++_i) \
        __builtin_amdgcn_global_load_lds((const unsigned*)((const char*)(gbase) + (voff)[_i]), (PG8_LAS unsigned*)(lds + (bufoff) + ldsw + _i * 8192), 16, 0, 0); } while (0)
#define PG8_LDA(dst, b, h) do { _Pragma("unroll") for (int m = 0; m < 4; ++m) _Pragma("unroll") for (int k = 0; k < 2; ++k) dst[m][k] = *(const PG8_LAS bf16x8*)(lds + PG8_SA(b, h) + aoff + m * 2048 + k * 1024); } while (0)
#define PG8_LDB(dst, b, h) do { _Pragma("unroll") for (int n = 0; n < 2; ++n) _Pragma("unroll") for (int k = 0; k < 2; ++k) dst[n][k] = *(const PG8_LAS bf16x8*)(lds + PG8_SB(b, h) + boff + n * 2048 + k * 1024); } while (0)
#define PG8_MMA(ai, bj, At, Bt) do { __builtin_amdgcn_s_setprio(1); _Pragma("unroll") for (int m = 0; m < 4; ++m) _Pragma("unroll") for (int n = 0; n < 2; ++n) _Pragma("unroll") for (int k = 0; k < 2; ++k) \
        acc[ai][bj][m][n] = __builtin_amdgcn_mfma_f32_16x16x32_bf16(Bt[n][k], At[m][k], acc[ai][bj][m][n], 0, 0, 0); __builtin_amdgcn_s_setprio(0); } while (0)
#define PG8_WAIT_V(n) asm volatile("s_waitcnt vmcnt(" #n ")" ::: "memory")
#define PG8_WAIT_L(n) asm volatile("s_waitcnt lgkmcnt(" #n ")" ::: "memory")
#define PG8_BAR __builtin_amdgcn_s_barrier()
#define PG8_SCHED __builtin_amdgcn_sched_barrier(0)
    Unit cur, nxt; int ui = 0;
    if (!S.next(0, cur)) return;
    f32x4 acc[2][2][4][2];
#pragma unroll
    for (int a = 0; a < 2; ++a)
#pragma unroll
        for (int b = 0; b < 2; ++b)
#pragma unroll
            for (int m = 0; m < 4; ++m)
#pragma unroll
                for (int n = 0; n < 2; ++n) acc[a][b][m][n] = (f32x4){0.f, 0.f, 0.f, 0.f};
    bf16x8 At[4][2], B0[2][2], B1[2][2];
    const char* cA = (const char*)g.A + (size_t)cur.pm * tstep; const char* cB = (const char*)g.Bt + (size_t)cur.pn * tstep;
    S.a_ready(cur);
    if constexpr (SP2) {
        PG8_STAGE(PG8_SB(0, 0), cB, voffB); PG8_STAGE(PG8_SB(0, 1), cB + hstep, voffB); PG8_STAGE(PG8_SA(0, 0), cA, voffA); PG8_STAGE(PG8_SA(0, 1), cA + hstep, voffA);
        if (wr == 1) PG8_BAR;
        PG8_WAIT_V(2); PG8_BAR;
        PG8_STAGE(PG8_SB(1, 0), cB + kstep, voffB); PG8_STAGE(PG8_SA(1, 0), cA + kstep, voffA); PG8_STAGE(PG8_SB(1, 1), cB + hstep + kstep, voffB);
        PG8_WAIT_V(6); PG8_BAR;
    } else {
        PG8_STAGE(PG8_SB(0, 0), cB, voffB); PG8_STAGE(PG8_SA(0, 0), cA, voffA); PG8_STAGE(PG8_SB(0, 1), cB + hstep, voffB); PG8_STAGE(PG8_SA(0, 1), cA + hstep, voffA);
        if (wr == 1) PG8_BAR;
        PG8_WAIT_V(4); PG8_BAR;
        PG8_STAGE(PG8_SB(1, 0), cB + kstep, voffB); PG8_STAGE(PG8_SA(1, 0), cA + kstep, voffA); PG8_STAGE(PG8_SB(1, 1), cB + hstep + kstep, voffB);
        PG8_WAIT_V(6); PG8_BAR;
    }
    for (;;) {
        const bool has_next = S.next(ui + 1, nxt);
        const char* nA = has_next ? (const char*)g.A + (size_t)nxt.pm * tstep : cA; const char* nB = has_next ? (const char*)g.Bt + (size_t)nxt.pn * tstep : cB;
        for (int t = 0; t < nt; t += 2) {
            const bool last = (t == nt - 2);
            const char* a1 = cA + (size_t)(t + 1) * kstep;
            const char* a2 = last ? nA : cA + (size_t)(t + 2) * kstep; const char* b2 = last ? nB : cB + (size_t)(t + 2) * kstep;
            const char* a3 = a2 + kstep; const char* b3 = b2 + kstep;
            if (last && has_next) S.a_ready(nxt);
            if constexpr (SP2) {
            PG8_LDB(B0, 0, 0); PG8_LDB(B1, 0, 1); PG8_SCHED; PG8_LDA(At, 0, 0); PG8_STAGE(PG8_SA(1, 1), a1 + hstep, voffA);
            PG8_WAIT_V(8); PG8_WAIT_L(0); PG8_BAR; PG8_MMA(0, 0, At, B0); PG8_MMA(0, 1, At, B1); PG8_BAR; PG8_SCHED;
            PG8_LDA(At, 0, 1); PG8_STAGE(PG8_SB(0, 0), b2, voffB); PG8_STAGE(PG8_SB(0, 1), b2 + hstep, voffB); PG8_STAGE(PG8_SA(0, 0), a2, voffA);
            PG8_WAIT_V(8); PG8_WAIT_L(0); PG8_BAR; PG8_MMA(1, 0, At, B0); PG8_MMA(1, 1, At, B1); PG8_BAR; PG8_SCHED;
            PG8_LDB(B0, 1, 0); PG8_LDB(B1, 1, 1); PG8_SCHED; PG8_LDA(At, 1, 0); PG8_STAGE(PG8_SA(0, 1), a2 + hstep, voffA);
            PG8_WAIT_V(8); PG8_WAIT_L(0); PG8_BAR; PG8_MMA(0, 0, At, B0); PG8_MMA(0, 1, At, B1); PG8_BAR; PG8_SCHED;
            PG8_LDA(At, 1, 1); PG8_STAGE(PG8_SB(1, 0), b3, voffB); PG8_STAGE(PG8_SB(1, 1), b3 + hstep, voffB); PG8_STAGE(PG8_SA(1, 0), a3, voffA);
            PG8_WAIT_V(8); PG8_WAIT_L(0); PG8_BAR; PG8_MMA(1, 0, At, B0); PG8_MMA(1, 1, At, B1); PG8_BAR; PG8_SCHED;
            } else {
            PG8_LDB(B0, 0, 0); PG8_SCHED; PG8_LDA(At, 0, 0); PG8_STAGE(PG8_SA(1, 1), a1 + hstep, voffA);
            PG8_WAIT_L(8); PG8_BAR; PG8_WAIT_L(0); PG8_MMA(0, 0, At, B0); PG8_BAR; PG8_SCHED;
            PG8_LDB(B1, 0, 1); PG8_STAGE(PG8_SB(0, 0), b2, voffB);
            PG8_BAR; PG8_WAIT_L(0); PG8_MMA(0, 1, At, B1); PG8_BAR;
            PG8_LDA(At, 0, 1); PG8_STAGE(PG8_SA(0, 0), a2, voffA);
            PG8_BAR; PG8_WAIT_L(0); PG8_MMA(1, 0, At, B0); PG8_BAR; PG8_SCHED;
            PG8_STAGE(PG8_SB(0, 1), b2 + hstep, voffB);
            PG8_WAIT_V(6); PG8_BAR; PG8_MMA(1, 1, At, B1); PG8_BAR;
            PG8_LDB(B0, 1, 0); PG8_SCHED; PG8_LDA(At, 1, 0); PG8_STAGE(PG8_SA(0, 1), a2 + hstep, voffA);
            PG8_WAIT_L(8); PG8_BAR; PG8_WAIT_L(0); PG8_MMA(0, 0, At, B0); PG8_BAR; PG8_SCHED;
            PG8_LDB(B1, 1, 1); PG8_STAGE(PG8_SB(1, 0), b3, voffB);
            PG8_BAR; PG8_WAIT_L(0); PG8_MMA(0, 1, At, B1); PG8_BAR;
            PG8_LDA(At, 1, 1); PG8_STAGE(PG8_SA(1, 0), a3, voffA);
            PG8_BAR; PG8_WAIT_L(0); PG8_MMA(1, 0, At, B0); PG8_BAR; PG8_SCHED;
            PG8_STAGE(PG8_SB(1, 1), b3 + hstep, voffB);
            PG8_WAIT_V(6); PG8_BAR; PG8_MMA(1, 1, At, B1); PG8_BAR;
            }
        }
        if constexpr (ALIGN_EPI) { if (wr == 0) PG8_BAR; }
        if constexpr (!Epi::AFTER_DRAIN) { E(acc, cur, wr, wc, fr, fq); S.done(cur); }
        if (!has_next) break;
#pragma unroll
        for (int a = 0; a < 2; ++a)
#pragma unroll
            for (int b = 0; b < 2; ++b)
#pragma unroll
                for (int m = 0; m < 4; ++m)
#pragma unroll
                    for (int n = 0; n < 2; ++n) acc[a][b][m][n] = (f32x4){0.f, 0.f, 0.f, 0.f};
        cur = nxt; cA = nA; cB = nB; ++ui;
        if constexpr (ALIGN_EPI) { if (wr == 1) PG8_BAR; }
    }
    PG8_WAIT_V(0);
    if constexpr (!ALIGN_EPI) { if (wr == 0) PG8_BAR; }
    PG8_BAR;
    if constexpr (Epi::AFTER_DRAIN) { E.fused(acc, cur, wr, wc, fr, fq, lds, wid, lane); S.done(cur); }
#undef PG8_SA
#undef PG8_SB
#undef PG8_STAGE
#undef PG8_LDA
#undef PG8_LDB
#undef PG8_MMA
#undef PG8_WAIT_V
#undef PG8_WAIT_L
#undef PG8_BAR
#undef PG8_SCHED
}
}
namespace pg8 {
typedef unsigned u32x2 __attribute__((ext_vector_type(2)));
__device__ __forceinline__ u32x4 pack8(f32x4 a, f32x4 b) { u32x4 w; w.x = cvt_pk_bf16(a[0], a[1]); w.y = cvt_pk_bf16(a[2], a[3]); w.z = cvt_pk_bf16(b[0], b[1]); w.w = cvt_pk_bf16(b[2], b[3]); return w; }
__device__ __forceinline__ f32x4 unpk_lo(u32x4 w) { return (f32x4){__uint_as_float(w.x << 16), __uint_as_float(w.x & 0xffff0000u), __uint_as_float(w.y << 16), __uint_as_float(w.y & 0xffff0000u)}; }
__device__ __forceinline__ f32x4 unpk_hi(u32x4 w) { return (f32x4){__uint_as_float(w.z << 16), __uint_as_float(w.z & 0xffff0000u), __uint_as_float(w.w << 16), __uint_as_float(w.w & 0xffff0000u)}; }
__device__ __forceinline__ float sigm1(float v) { return __builtin_amdgcn_rcpf(1.0f + __builtin_amdgcn_exp2f(v * -1.4426950408889634f)); }
template <int ACT> __device__ __forceinline__ f32x4 act4(f32x4 v) {
    if (ACT == 1) { const f32x2 a = gelu_pk((f32x2){v[0], v[1]}), b = gelu_pk((f32x2){v[2], v[3]}); return (f32x4){a.x, a.y, b.x, b.y}; }
    if (ACT == 2) { return (f32x4){v[0] * sigm1(v[0]), v[1] * sigm1(v[1]), v[2] * sigm1(v[2]), v[3] * sigm1(v[3])}; }
    if (ACT == 3) { return (f32x4){sigm1(v[0]), sigm1(v[1]), sigm1(v[2]), sigm1(v[3])}; }
    return v;
}
struct EpiG1 {
    static constexpr bool PERM = true, AFTER_DRAIN = false;
    int seg0; bf16_t *d0, *d1, *d2, *d3, *d4, *d5, *d6;
    const float* cosT; const float* sinT; f32x2* stats;
    template <int ACT, bool STATS> __device__ __forceinline__ void body(const f32x4 (&acc)[2][2][4][2], const Unit& u, bf16_t* dst, int wr, int wc, int fr, int fq) const {
        const int row0 = u.pm * BM + wr * 64 + fr, colt = (u.pn & 3) * BM + wc * 32 + 8 * fq;
#pragma unroll
        for (int ai = 0; ai < 2; ++ai)
#pragma unroll
            for (int m = 0; m < 4; ++m) { const int row = row0 + ai * HALF + m * 16; bf16_t* rowp = dst + (size_t)row * 1024 + colt; float s = 0.f, ss = 0.f;
#pragma unroll
                for (int bj = 0; bj < 2; ++bj) { const f32x4 v0 = act4<ACT>(acc[ai][bj][m][0]), v1 = act4<ACT>(acc[ai][bj][m][1]);
                    if (STATS) { s += (v0[0] + v0[1]) + (v0[2] + v0[3]) + (v1[0] + v1[1]) + (v1[2] + v1[3]);
                                 ss += (v0[0] * v0[0] + v0[1] * v0[1]) + (v0[2] * v0[2] + v0[3] * v0[3]) + (v1[0] * v1[0] + v1[1] * v1[1]) + (v1[2] * v1[2] + v1[3] * v1[3]); }
                    *(u32x4*)(rowp + bj * HALF) = pack8(v0, v1); }
                if (STATS) { s += __shfl_xor(s, 16); s += __shfl_xor(s, 32); ss += __shfl_xor(ss, 16); ss += __shfl_xor(ss, 32);
                             if (fq == 0) stats[(size_t)row * 16 + (u.pn & 3) * 4 + wc] = (f32x2){s, ss}; } }
    }
    __device__ __forceinline__ void operator()(const f32x4 (&acc)[2][2][4][2], const Unit& u, int wr, int wc, int fr, int fq) const {
        const int sl = u.pn >> 2, sg = seg0 + sl;
        bf16_t* dst = sl == 0 ? d0 : sl == 1 ? d1 : sl == 2 ? d2 : sl == 3 ? d3 : sl == 4 ? d4 : sl == 5 ? d5 : d6;
        if (sg == 3 || sg == 4) {
            const float sc = sg == 3 ? 0.125f : 1.0f;
            const int row0 = u.pm * BM + wr * 64 + fr, coln = (u.pn & 3) * BM + (wc >> 1) * 128 + (wc & 1) * 64 + 8 * fq;
#pragma unroll
            for (int ai = 0; ai < 2; ++ai)
#pragma unroll
                for (int m = 0; m < 4; ++m) { const int row = row0 + ai * HALF + m * 16;
                    const f32x4 c0 = *(const f32x4*)(cosT + (size_t)row * 32 + 8 * fq), c1 = *(const f32x4*)(cosT + (size_t)row * 32 + 8 * fq + 4);
                    const f32x4 s0 = *(const f32x4*)(sinT + (size_t)row * 32 + 8 * fq), s1 = *(const f32x4*)(sinT + (size_t)row * 32 + 8 * fq + 4);
                    const f32x4 t1a = acc[ai][0][m][0], t1b = acc[ai][0][m][1], t2a = acc[ai][1][m][0], t2b = acc[ai][1][m][1];
                    const f32x4 o1a = (t1a * c0 - t2a * s0) * sc, o1b = (t1b * c1 - t2b * s1) * sc, o2a = (t2a * c0 + t1a * s0) * sc, o2b = (t2b * c1 + t1b * s1) * sc;
                    bf16_t* rp = dst + (size_t)row * 1024 + coln;
                    *(u32x4*)rp = pack8(o1a, o1b); *(u32x4*)(rp + 32) = pack8(o2a, o2b); asm volatile("" ::: "memory"); }
        }
#if defined(MK_RAW_ACT)
        else if (sg >= 5) body<0, false>(acc, u, dst, wr, wc, fr, fq);
#endif
        else if (sg == 0) body<1, false>(acc, u, dst, wr, wc, fr, fq);
        else if (sg == 1) body<1, true>(acc, u, dst, wr, wc, fr, fq);
        else if (sg == 2 || sg == 6) body<2, false>(acc, u, dst, wr, wc, fr, fq);
        else if (sg == 5) body<0, false>(acc, u, dst, wr, wc, fr, fq);
        else body<3, false>(acc, u, dst, wr, wc, fr, fq);
    }
};
struct EpiGate {
    static constexpr bool PERM = true, AFTER_DRAIN = false;
    const bf16_t* gate; const bf16_t* add; bf16_t* out;
    __device__ __forceinline__ void operator()(const f32x4 (&acc)[2][2][4][2], const Unit& u, int wr, int wc, int fr, int fq) const {
        const int row0 = u.pm * BM + wr * 64 + fr, col0 = u.pn * BM + wc * 32 + 8 * fq;
#pragma unroll
        for (int ai = 0; ai < 2; ++ai)
#pragma unroll
            for (int m = 0; m < 4; ++m)
#pragma unroll
                for (int bj = 0; bj < 2; ++bj) { const size_t off = (size_t)(row0 + ai * HALF + m * 16) * 1024 + col0 + bj * HALF;
                    const u32x4 g = *(const u32x4*)(gate + off);
                    f32x4 v0 = acc[ai][bj][m][0] * unpk_lo(g), v1 = acc[ai][bj][m][1] * unpk_hi(g);
                    if (add) { const u32x4 a = *(const u32x4*)(add + off); v0 += unpk_lo(a); v1 += unpk_hi(a); }
                    *(u32x4*)(out + off) = pack8(v0, v1); if (bj == 1) asm volatile("" ::: "memory"); }
    }
};
struct EpiRes {
    static constexpr bool PERM = false, AFTER_DRAIN = false;
    const float* x; const bf16_t* pg; float* out; float alpha;
    __device__ __forceinline__ void operator()(const f32x4 (&acc)[2][2][4][2], const Unit& u, int wr, int wc, int fr, int fq) const {
        const int row0 = u.pm * BM + wr * 64 + fr, col0 = u.pn * BM + wc * 32 + 4 * fq;
#pragma unroll
        for (int ai = 0; ai < 2; ++ai)
#pragma unroll
            for (int m = 0; m < 4; ++m)
#pragma unroll
                for (int bj = 0; bj < 2; ++bj)
#pragma unroll
                    for (int n = 0; n < 2; ++n) { const size_t off = (size_t)(row0 + ai * HALF + m * 16) * 1024 + col0 + bj * HALF + n * 16;
                        const u32x2 g = *(const u32x2*)(pg + off); const f32x4 xv = *(const f32x4*)(x + off);
                        const f32x4 gf = (f32x4){__uint_as_float(g.x << 16), __uint_as_float(g.x & 0xffff0000u), __uint_as_float(g.y << 16), __uint_as_float(g.y & 0xffff0000u)};
                        *(f32x4*)(out + off) = xv * alpha + gf * acc[ai][bj][m][n]; if (bj == 1 && n == 1) asm volatile("" ::: "memory"); }
    }
};
struct EpiY {
    static constexpr bool PERM = false, AFTER_DRAIN = false;
    float* Y; f32x2* stats;
    __device__ __forceinline__ void operator()(const f32x4 (&acc)[2][2][4][2], const Unit& u, int wr, int wc, int fr, int fq) const {
        const int row0 = u.pm * BM + wr * 64 + fr, col0 = u.pn * BM + wc * 32 + 4 * fq;
#pragma unroll
        for (int ai = 0; ai < 2; ++ai)
#pragma unroll
            for (int m = 0; m < 4; ++m) { const int row = row0 + ai * HALF + m * 16; float s = 0.f, ss = 0.f;
#pragma unroll
                for (int bj = 0; bj < 2; ++bj)
#pragma unroll
                    for (int n = 0; n < 2; ++n) { const size_t off = (size_t)row * 1024 + col0 + bj * HALF + n * 16;
                        const f32x4 y = *(const f32x4*)(Y + off) + acc[ai][bj][m][n];
                        s += (y[0] + y[1]) + (y[2] + y[3]); ss += (y[0] * y[0] + y[1] * y[1]) + (y[2] * y[2] + y[3] * y[3]);
                        *(f32x4*)(Y + off) = y; }
                s += __shfl_xor(s, 16); s += __shfl_xor(s, 32); ss += __shfl_xor(ss, 16); ss += __shfl_xor(ss, 32);
                if (fq == 0) stats[(size_t)row * 16 + u.pn * 4 + wc] = (f32x2){s, ss}; asm volatile("" ::: "memory"); }
    }
};
}
namespace att {
typedef unsigned short bf16_t;
typedef short bf16x8 __attribute__((ext_vector_type(8)));
typedef short s16x4 __attribute__((ext_vector_type(4)));
typedef float f32x16 __attribute__((ext_vector_type(16)));
typedef float f32x4 __attribute__((ext_vector_type(4)));
typedef unsigned u32x4 __attribute__((ext_vector_type(4)));
constexpr int NW = 8, QBLK = 32, KVBLK = 64, QBU = 128, D = 128, DMP = 1024, SEQ_ = 8192;
constexpr int SHM_V = KVBLK * D * 2, SHM_K = KVBLK * D * 2;
constexpr int LDS_WS = 2 * SHM_V + 2 * SHM_K;
constexpr int LDS_ES = LDS_WS + NW * 64 * 4;
constexpr int ES_STRIDE = 132, ES_QB = 32 * ES_STRIDE;
constexpr int LDS_BYTES = LDS_ES + 4 * ES_QB * 4;
constexpr float LOG2E = 1.4426950408889634f;
constexpr float THR = 8.f;

#define KSWZ(row, colB) ((row) * 256 + ((colB) ^ (((row) & 7) << 4)))
#define SBAR() __builtin_amdgcn_sched_barrier(0)
__device__ __forceinline__ int v_st(int k, int c) { const int kk = (k & ~0xC) | ((k & 4) << 1) | ((k & 8) >> 1); return ((kk >> 3) * 4 + (c >> 5)) * 512 + ((kk & 7) * 32 + (c & 31)) * 2; }
__device__ __forceinline__ int v_rd_base(int lane) { return ((lane & 3) << 3) | (((lane >> 2) & 3) << 6) | (((lane >> 4) & 1) << 5) | (((lane >> 5) & 1) << 8); }
constexpr int v_rd_off(int d0, int ks, int half) { return d0 * 512 + ks * 4096 + half * 2048; }
__device__ __forceinline__ int crow(int r, int hi) { return (r & 3) + 8 * (r >> 2) + 4 * hi; }
typedef float f32x2_cv __attribute__((ext_vector_type(2))); typedef __bf16 bf16x2_cv __attribute__((ext_vector_type(2)));
__device__ __forceinline__ unsigned cvtpk(float lo, float hi) { f32x2_cv v = {lo, hi}; bf16x2_cv b = __builtin_convertvector(v, bf16x2_cv); return __builtin_bit_cast(unsigned, b); }
__device__ __forceinline__ bf16x8 load8(const bf16_t* p) { return *reinterpret_cast<const bf16x8*>(p); }
__device__ __forceinline__ void mask_tile(f32x16& p0, f32x16& p1, int dq) {
    const float NEG = -__builtin_inff();
#pragma unroll
    for (int r = 0; r < 16; ++r) { const int c = (r & 3) + 8 * (r >> 2); if (dq - c < 0) p0[r] = NEG; if (dq - c - 32 < 0) p1[r] = NEG; }
}
__device__ __forceinline__ void partialSM(f32x16& p0, f32x16& p1, float& m_reg, float& mn, float& alpha) {
    float pmax = p0[0];
#pragma unroll
    for (int r = 1; r < 16; ++r) pmax = fmaxf(pmax, p0[r]);
#pragma unroll
    for (int r = 0; r < 16; ++r) pmax = fmaxf(pmax, p1[r]);
    { auto rr = __builtin_amdgcn_permlane32_swap(__float_as_uint(pmax), __float_as_uint(pmax), false, false);
      pmax = fmaxf(__uint_as_float(rr[0]), __uint_as_float(rr[1])); }
    if (__builtin_expect(__all((pmax - m_reg) <= THR), 1)) { mn = m_reg; alpha = 1.f; }
    else { mn = fmaxf(m_reg, pmax); alpha = __builtin_amdgcn_exp2f((m_reg - mn) * LOG2E); m_reg = mn; }
    const float mnL = -mn * LOG2E;
#pragma unroll
    for (int r = 0; r < 16; ++r) p0[r] = fmaf(p0[r], LOG2E, mnL);
#pragma unroll
    for (int r = 0; r < 16; ++r) p1[r] = fmaf(p1[r], LOG2E, mnL);
#pragma unroll
    for (int r = 0; r < 16; ++r) p0[r] = __builtin_amdgcn_exp2f(p0[r]);
}
__device__ __forceinline__ void finishSM(f32x16& p0, f32x16& p1, float alpha, float& l_reg, bf16x8& pa0, bf16x8& pa1, bf16x8& pa2, bf16x8& pa3) {
#pragma unroll
    for (int r = 0; r < 16; ++r) p1[r] = __builtin_amdgcn_exp2f(p1[r]);
    float ps = 0;
#pragma unroll
    for (int r = 0; r < 16; ++r) ps += p0[r];
#pragma unroll
    for (int r = 0; r < 16; ++r) ps += p1[r];
    { auto rr = __builtin_amdgcn_permlane32_swap(__float_as_uint(ps), __float_as_uint(ps), false, false);
      ps = __uint_as_float(rr[0]) + __uint_as_float(rr[1]); }
    l_reg = l_reg * alpha + ps;
#define PK4(P, B_, OUT) do { unsigned a0 = cvtpk(P[B_+0], P[B_+1]), a1 = cvtpk(P[B_+2], P[B_+3]);                          \
        unsigned b0 = cvtpk(P[B_+4], P[B_+5]), b1 = cvtpk(P[B_+6], P[B_+7]);                                             \
        auto r0 = __builtin_amdgcn_permlane32_swap(a0, b0, false, false); auto r1 = __builtin_amdgcn_permlane32_swap(a1, b1, false, false); \
        u32x4 w = {r0[0], r1[0], r0[1], r1[1]}; OUT = *reinterpret_cast<bf16x8*>(&w); } while (0)
    PK4(p0, 0, pa0); PK4(p0, 8, pa1); PK4(p1, 0, pa2); PK4(p1, 8, pa3);
#undef PK4
}
template <int KB>
__device__ __forceinline__ void qkt(f32x16& p0, f32x16& p1, const char* K_lds, int r32, int hi, int map, const bf16x8* qr) {
    p0 = f32x16{}; p1 = f32x16{};
    const char* kb[4];
#pragma unroll
    for (int dd = 0; dd < 4; ++dd) kb[dd] = K_lds + KB * SHM_K + KSWZ(r32, (dd * 16 + hi * 8) * 2) + map * 128;
#pragma unroll
    for (int d0 = 0; d0 < 4; ++d0) { const char* a = kb[d0];
        bf16x8 b0 = *reinterpret_cast<const bf16x8*>(a);
        bf16x8 b1 = *reinterpret_cast<const bf16x8*>(a + 32 * 256);
        p0 = __builtin_amdgcn_mfma_f32_32x32x16_bf16(b0, qr[d0], p0, 0, 0, 0);
        p1 = __builtin_amdgcn_mfma_f32_32x32x16_bf16(b1, qr[d0], p1, 0, 0, 0); }
}
template <int VB>
__device__ __forceinline__ void pv_tile(f32x16* o, int vb0, bf16x8 pa0, bf16x8 pa1, bf16x8 pa2, bf16x8 pa3) {
#define TRRD(dst, off) asm volatile("ds_read_b64_tr_b16 %0, %1 offset:%2" : "=&v"(dst) : "v"(vb0), "i"(off) : "memory")
#define PV_D0(d0) do { s16x4 l0, l1, l2, l3, h0, h1, h2, h3; constexpr int b_ = VB * SHM_V + v_rd_off(d0, 0, 0);     \
        TRRD(l0, b_); TRRD(h0, b_ + 2048); TRRD(l1, b_ + 4096); TRRD(h1, b_ + 6144); TRRD(l2, b_ + 8192); TRRD(h2, b_ + 10240); TRRD(l3, b_ + 12288); TRRD(h3, b_ + 14336); \
        asm volatile("s_waitcnt lgkmcnt(0)" ::: "memory"); SBAR();                 \
        o[d0] = __builtin_amdgcn_mfma_f32_32x32x16_bf16(pa0, (bf16x8){l0[0], l0[1], l0[2], l0[3], h0[0], h0[1], h0[2], h0[3]}, o[d0], 0, 0, 0);   \
        o[d0] = __builtin_amdgcn_mfma_f32_32x32x16_bf16(pa1, (bf16x8){l1[0], l1[1], l1[2], l1[3], h1[0], h1[1], h1[2], h1[3]}, o[d0], 0, 0, 0);   \
        o[d0] = __builtin_amdgcn_mfma_f32_32x32x16_bf16(pa2, (bf16x8){l2[0], l2[1], l2[2], l2[3], h2[0], h2[1], h2[2], h2[3]}, o[d0], 0, 0, 0);   \
        o[d0] = __builtin_amdgcn_mfma_f32_32x32x16_bf16(pa3, (bf16x8){l3[0], l3[1], l3[2], l3[3], h3[0], h3[1], h3[2], h3[3]}, o[d0], 0, 0, 0); } while (0)
    PV_D0(0); PV_D0(1); PV_D0(2); PV_D0(3);
#undef PV_D0
#undef TRRD
}
struct BlockRef { const bf16_t* Q; const bf16_t* K; const bf16_t* V; bf16_t* O; int P0; };
struct Seam { bf16x8 qr[4]; bf16x8 st_v0, st_v1, st_k0, st_k1; };
#define ROW(p, k0, rr) ((p) + (size_t)((k0) + (rr)) * DMP + sc)
#define VMW() asm volatile("s_waitcnt vmcnt(0)" ::: "memory")
#define VMWN(n) asm volatile("s_waitcnt vmcnt(%0)" :: "i"(n) : "memory")
#define SLOAD_H(Kp, Vp, k0) do { S.st_v0 = load8(ROW(Vp, k0, sr)); S.st_v1 = load8(ROW(Vp, k0, 32 + sr));              \
                         S.st_k0 = load8(ROW(Kp, k0, sr)); S.st_k1 = load8(ROW(Kp, k0, 32 + sr)); } while (0)
#define SWRITE_HK(bf) do { *(bf16x8*)(K_lds + (bf) * SHM_K + kws) = S.st_k0; *(bf16x8*)(K_lds + (bf) * SHM_K + kws + 32 * 256) = S.st_k1; } while (0)
#define SWRITE_HV(bf) do { *(bf16x8*)(V_lds + (bf) * SHM_V + vst0) = S.st_v0; *(bf16x8*)(V_lds + (bf) * SHM_V + vst1) = S.st_v1; } while (0)
#define SWRITE_H(bf) do { SWRITE_HV(bf); SWRITE_HK(bf); } while (0)
__device__ __forceinline__ void attn_prime(const BlockRef& cur, char* lds, Seam& S) {
    int tid_ = threadIdx.x; asm volatile("" : "+v"(tid_));
    const int tid = tid_, wid = __builtin_amdgcn_readfirstlane(tid >> 6), lane = tid & 63, r32 = lane & 31, hi = lane >> 5;
    const int map = wid >> 2, qw = wid & 3;
    const int sr = tid >> 4, sc = (tid & 15) * 8, kws = KSWZ(sr, sc * 2); char* K_lds = lds + 2 * SHM_V;
#pragma unroll
    for (int d0 = 0; d0 < 4; ++d0) S.qr[d0] = load8(cur.Q + (size_t)(qw * QBLK + r32) * DMP + map * 64 + d0 * 16 + hi * 8);
    SLOAD_H(cur.K, cur.V, 0); VMW(); SWRITE_HK(0);
    __syncthreads();
}
__device__ __forceinline__ void attn_block(const BlockRef& cur, const BlockRef& nxt, char* lds, Seam& S, float lam, const float* subg) {
    int tid_ = threadIdx.x; asm volatile("" : "+v"(tid_));
    const int tid = tid_, wid = __builtin_amdgcn_readfirstlane(tid >> 6), lane = tid & 63, r32 = lane & 31, hi = lane >> 5;
    const int map = wid >> 2, qw = wid & 3;
    const int NT = (cur.P0 + QBU) / KVBLK;
    const int qlo = cur.P0 + qw * QBLK, qm = qlo + r32 - 4 * hi;
    char* V_lds = lds; char* K_lds = lds + 2 * SHM_V;
    float* ws = (float*)(lds + LDS_WS) + wid * 64; float* li_l = ws, * al_l = ws + 32;
    float m_reg = -1e30f, l_reg = 0; f32x16 o[4] = {};
    const int sr = tid >> 4, sc = (tid & 15) * 8, vst0 = v_st(sr, sc), vst1 = v_st(32 + sr, sc), kws = KSWZ(sr, sc * 2);
    const int vb0 = (int)(uintptr_t)V_lds + v_rd_base(lane);
    const bf16_t* Kh = cur.K; const bf16_t* Vh = cur.V;
#define RESC(a) do { if (__any((a) < 1.f)) { if (hi == 0) al_l[r32] = (a); asm volatile("s_waitcnt lgkmcnt(0)" ::: "memory");              \
                     for (int d_ = 0; d_ < 4; ++d_) for (int r = 0; r < 16; ++r) o[d_][r] *= al_l[crow(r, hi)]; } } while (0)
#define KBASE(t) ((t) * KVBLK)
#define MASKT(P0_, P1_, t) do { const int kb_ = KBASE(t); if (kb_ + KVBLK - 1 > qlo) mask_tile(P0_, P1_, qm - kb_); } while (0)
    constexpr int NQL = 4;
#define SEAM_K0() do { VMWN(NQL); SWRITE_HK(0); SBAR(); } while (0)
    f32x16 pA0, pA1, pB0, pB1; float mnA, mnB, alA, alB; bf16x8 pa0, pa1, pa2, pa3;
    SWRITE_HV(0); SBAR();
    SLOAD_H(Kh, Vh, KBASE(1));
    SBAR(); qkt<0>(pA0, pA1, K_lds, r32, hi, map, S.qr);
    MASKT(pA0, pA1, 0); partialSM(pA0, pA1, m_reg, mnA, alA);
    VMW(); SWRITE_H(1);
    __syncthreads();
#define HALF_STEP(PX0, PX1, mnX, alX, PY0, PY1, alY, t, KB, VB, SB) do {                                                      \
        SBAR(); qkt<KB>(PX0, PX1, K_lds, r32, hi, map, S.qr);                                                                 \
        finishSM(PY0, PY1, alY, l_reg, pa0, pa1, pa2, pa3); SBAR();                                                           \
        if ((t) + 1 < NT) { SLOAD_H(Kh, Vh, KBASE((t) + 1)); SBAR(); }                                                       \
        pv_tile<VB>(o, vb0, pa0, pa1, pa2, pa3); MASKT(PX0, PX1, (t)); partialSM(PX0, PX1, m_reg, mnX, alX);                  \
        __syncthreads();                                                                                                      \
        if ((t) + 1 < NT) { VMW(); SWRITE_H(SB); }                                                                            \
        RESC(alX); __syncthreads(); } while (0)
    for (int t = 1; t + 1 < NT; t += 2) {
        HALF_STEP(pB0, pB1, mnB, alB, pA0, pA1, alA, t, 1, 0, 0);
        HALF_STEP(pA0, pA1, mnA, alA, pB0, pB1, alB, t + 1, 0, 1, 1);
    }
    SBAR(); qkt<1>(pB0, pB1, K_lds, r32, hi, map, S.qr); SBAR();
    SLOAD_H(nxt.K, nxt.V, 0); SBAR();
#pragma unroll
    for (int d0 = 0; d0 < 4; ++d0) S.qr[d0] = load8(nxt.Q + (size_t)(qw * QBLK + r32) * DMP + map * 64 + d0 * 16 + hi * 8);
    SBAR();
    finishSM(pA0, pA1, alA, l_reg, pa0, pa1, pa2, pa3); SBAR();
    pv_tile<0>(o, vb0, pa0, pa1, pa2, pa3);
    MASKT(pB0, pB1, NT - 1); partialSM(pB0, pB1, m_reg, mnB, alB); __syncthreads(); RESC(alB);
    finishSM(pB0, pB1, alB, l_reg, pa0, pa1, pa2, pa3); SBAR(); pv_tile<1>(o, vb0, pa0, pa1, pa2, pa3);
    SBAR(); SEAM_K0();
    if (hi == 0) li_l[r32] = l_reg; asm volatile("s_waitcnt lgkmcnt(0)" ::: "memory");
    float rli[16];
#pragma unroll
    for (int r = 0; r < 16; ++r) rli[r] = __builtin_amdgcn_rcpf(li_l[crow(r, hi)]);
    float* es = (float*)(lds + LDS_ES) + qw * ES_QB;
    if (map == 1) {
#pragma unroll
        for (int r = 0; r < 16; ++r) { const int orow = crow(r, hi); const float f = lam * rli[r];
#pragma unroll
            for (int d0 = 0; d0 < 4; ++d0) es[orow * ES_STRIDE + d0 * 32 + r32] = o[d0][r] * f; }
    }
    __syncthreads();
    if (map == 0) {
#pragma unroll
        for (int r = 0; r < 16; ++r) { const int orow = crow(r, hi);
#pragma unroll
            for (int d0 = 0; d0 < 4; ++d0) { float* pp = es + orow * ES_STRIDE + d0 * 32 + r32; *pp = o[d0][r] * rli[r] - *pp; } }
        asm volatile("s_waitcnt lgkmcnt(0)" ::: "memory");
        const int c0 = (lane & 7) * 16;
        f32x4 gsub[4];
#pragma unroll
        for (int k = 0; k < 4; ++k) gsub[k] = *(const f32x4*)(subg + c0 + 4 * k);
#pragma unroll
        for (int ps = 0; ps < 4; ++ps) { const int row = ps * 8 + (lane >> 3);
            f32x4 v[4]; float ss = 0.f;
#pragma unroll
            for (int k = 0; k < 4; ++k) { v[k] = *(const f32x4*)(es + row * ES_STRIDE + c0 + 4 * k); ss += (v[k][0] * v[k][0] + v[k][1] * v[k][1]) + (v[k][2] * v[k][2] + v[k][3] * v[k][3]); }
            ss += __shfl_xor(ss, 1); ss += __shfl_xor(ss, 2); ss += __shfl_xor(ss, 4);
            const float rs = rsqrtf(ss * (1.f / 128.f) + 1e-5f) * 0.8f;
            bf16_t* zp = cur.O + (size_t)(qw * QBLK + row) * DMP + c0;
            const u32x4 z0 = *(const u32x4*)zp, z1 = *(const u32x4*)(zp + 8);
            const unsigned zw[8] = {z0.x, z0.y, z0.z, z0.w, z1.x, z1.y, z1.z, z1.w};
            unsigned ow[8];
#pragma unroll
            for (int k = 0; k < 4; ++k) { const f32x4 t = v[k] * gsub[k] * rs;
                ow[2 * k] = cvtpk(t[0] * __uint_as_float(zw[2 * k] << 16), t[1] * __uint_as_float(zw[2 * k] & 0xffff0000u));
                ow[2 * k + 1] = cvtpk(t[2] * __uint_as_float(zw[2 * k + 1] << 16), t[3] * __uint_as_float(zw[2 * k + 1] & 0xffff0000u)); }
            *(u32x4*)zp = (u32x4){ow[0], ow[1], ow[2], ow[3]}; *(u32x4*)(zp + 8) = (u32x4){ow[4], ow[5], ow[6], ow[7]}; }
    }
    __syncthreads();
#undef RESC
#undef KBASE
#undef MASKT
#undef SEAM_K0
#undef HALF_STEP
}
#undef ROW
#undef VMW
#undef VMWN
#undef SLOAD_H
#undef SWRITE_HK
#undef SWRITE_HV
#undef SWRITE_H
__device__ __forceinline__ BlockRef unit_ref(int P, int second, const bf16_t* Q, const bf16_t* K, const bf16_t* V, bf16_t* ZB) {
    const int bh = P >> 5, k = P & 31, qb = second ? 63 - k : k, b = bh >> 3, h = bh & 7;
    BlockRef r; const size_t qoff = ((size_t)b * SEQ_ + (size_t)qb * QBU) * DMP + h * 128, koff = (size_t)b * SEQ_ * DMP + h * 128;
    r.Q = Q + qoff; r.O = ZB + qoff; r.K = K + koff; r.V = V + koff; r.P0 = qb * QBU; return r;
}
__device__ __forceinline__ void attn_phase(char* lds, const bf16_t* Q, const bf16_t* K, const bf16_t* V, bf16_t* ZB, int vcu, int G, float lam, const float* subg) {
    if (vcu >= 1024) return;
    int P = vcu, second = 0;
    BlockRef cur = unit_ref(P, 0, Q, K, V, ZB);
    Seam S;
    attn_prime(cur, lds, S);
    for (;;) {
        int Pn = P, sn = 1; bool last = false;
        if (second) { sn = 0; Pn = P + G; if (Pn >= 1024) { last = true; Pn = P; sn = 1; } }
        const BlockRef nxt = last ? cur : unit_ref(Pn, sn, Q, K, V, ZB);
        attn_block(cur, nxt, lds, S, lam, subg);
        if (last) break;
        cur = nxt; P = Pn; second = sn;
    }
}
#undef KSWZ
#undef SBAR
}
constexpr int NWAVES = 8;
#ifndef MK_N_LAUNCHES
#define MK_N_LAUNCHES 1
#endif
constexpr int NPHASE = 8;
constexpr int N_LAUNCHES = MK_N_LAUNCHES;
static_assert(N_LAUNCHES == 1 || N_LAUNCHES == NPHASE, "MK_N_LAUNCHES is 1 or 8");

constexpr int BATCH = 4, SEQ = 8192, DM = 1024, M = BATCH * SEQ, PLE = 256, INW = 9216, N1 = INW + DM;
constexpr float LN_EPS = 1e-5f;
constexpr float ALPHA = 1.189207115002721f;
constexpr float LAM_INIT = 0.2f;

constexpr size_t MiB = 1u << 20;
constexpr size_t WS_CTL = 0, CTL_ZERO_BYTES = 64 * 1024;
constexpr size_t WS_W1T = 1 * MiB, WS_WAT = 21 * MiB, WS_WBT = 23 * MiB, WS_WOT = 25 * MiB, WS_WPLT = 27 * MiB, WS_WSB = 27 * MiB + 512 * 1024;
constexpr size_t WS_COS = 28 * MiB, WS_SIN = 32 * MiB, WS_STATS = 36 * MiB, WS_PB = 40 * MiB, WS_XB = 56 * MiB;
constexpr size_t WS_SEG0 = 120 * MiB, WS_SEG1 = 184 * MiB, WS_SEG2 = 248 * MiB, WS_SEG3 = 312 * MiB, WS_SEG4 = 376 * MiB, WS_SEG5 = 440 * MiB, WS_END = 504 * MiB;
constexpr int CW_TMO = 0, CW_CODE = 1, CW_BAR = 4096;

constexpr int RING_OFF = 0, RING_BYTES = 135168;
constexpr int LDSCTL_OFF = RING_BYTES, MISC_OFF = LDSCTL_OFF + 320;
constexpr int LDS_BYTES = 139264;
static_assert(att::LDS_BYTES <= RING_BYTES && pg8::STAGE_BYTES <= RING_BYTES && MISC_OFF + 128 <= LDS_BYTES, "LDS map");

#define GAS __attribute__((address_space(1)))
#define LAS __attribute__((address_space(3)))
typedef unsigned short bf16;
typedef unsigned v4u __attribute__((ext_vector_type(4)));
typedef unsigned v2u __attribute__((ext_vector_type(2)));
typedef float f32x4 __attribute__((ext_vector_type(4)));
typedef float f32x2 __attribute__((ext_vector_type(2)));
typedef float f32x16 __attribute__((ext_vector_type(16)));
typedef short bf16x8 __attribute__((ext_vector_type(8)));
typedef short s16x4 __attribute__((ext_vector_type(4)));
typedef GAS unsigned gu32;
#define RLX_AGENT __ATOMIC_RELAXED, __HIP_MEMORY_SCOPE_AGENT
#define LDS_WAIT() asm volatile("s_waitcnt lgkmcnt(0)" ::: "memory")
#define VM_WAIT() asm volatile("s_waitcnt vmcnt(0)" ::: "memory")
__device__ __forceinline__ unsigned f2bf(float f) { unsigned u = __builtin_bit_cast(unsigned, f); return (u + 0x7fffu + ((u >> 16) & 1u)) >> 16; }
__device__ __forceinline__ unsigned pk2(float lo, float hi) { return f2bf(lo) | (f2bf(hi) << 16); }
__device__ __forceinline__ float bflo(unsigned w) { return __uint_as_float(w << 16); }
__device__ __forceinline__ float bfhi(unsigned w) { return __uint_as_float(w & 0xffff0000u); }
__device__ __forceinline__ float wave_sum(float v) {
#pragma unroll
    for (int o = 1; o < 64; o <<= 1) v += __shfl_xor(v, o);
    return v;
}
__device__ const float INVF[32] = {
    1.000000000e+00f, 7.498942018e-01f, 5.623413324e-01f, 4.216965139e-01f, 3.162277639e-01f, 2.371373773e-01f, 1.778279394e-01f, 1.333521456e-01f,
    1.000000015e-01f, 7.498942316e-02f, 5.623413250e-02f, 4.216964915e-02f, 3.162277490e-02f, 2.371373773e-02f, 1.778279431e-02f, 1.333521400e-02f,
    9.999999776e-03f, 7.498942316e-03f, 5.623413250e-03f, 4.216964822e-03f, 3.162277630e-03f, 2.371373819e-03f, 1.778279431e-03f, 1.333521446e-03f,
    1.000000047e-03f, 7.498941850e-04f, 5.623413017e-04f, 4.216965172e-04f, 3.162277571e-04f, 2.371373703e-04f, 1.778279402e-04f, 1.333521504e-04f};

#define XB_TMO      128
#define XB_XCNT(j)  (256  + 64 * (j))
#define XB_XSUB(j)  (1280 + 64 * (j))
#define XB_XGEN(j)  (2304 + 64 * (j))
#define XB_TOP      3328
#define XB_TOPGEN   3392
#define XCD_BAR_WORDS 3456
#define XB_SPIN_CAP (1u << 18)

__device__ __forceinline__ unsigned xb_ld(unsigned* p)              { return __hip_atomic_load(p, __ATOMIC_RELAXED, __HIP_MEMORY_SCOPE_AGENT); }
__device__ __forceinline__ unsigned xb_add(unsigned* p, unsigned v) { return __hip_atomic_fetch_add(p, v, __ATOMIC_RELAXED, __HIP_MEMORY_SCOPE_AGENT); }
__device__ __forceinline__ unsigned xb_xcc_id() { return (unsigned)__builtin_amdgcn_s_getreg((3 << 11) | 20) & 0xFu; }
#define XB_SPIN(cond, bar) do { unsigned _sp = 0; while (cond) { __builtin_amdgcn_s_sleep(1); \
    if ((++_sp & 255u) == 0u) { if (xb_ld(&(bar)[XB_TMO])) break; if (_sp > XB_SPIN_CAP) { atomicAdd(&(bar)[XB_TMO], 1u); break; } } } } while (0)

struct XcdBarrier {
    unsigned* bar; unsigned x;
    volatile LAS unsigned* st;
};

__device__ __forceinline__ XcdBarrier xcd_barrier_post(unsigned* bar, volatile LAS unsigned* st) {
    XcdBarrier b; b.bar = bar; b.x = xb_xcc_id(); b.st = st;
    if (threadIdx.x == 0) (void)xb_add(&bar[XB_XCNT(b.x)], 1u);
    return b;
}
__device__ __forceinline__ void xcd_barrier_complete(unsigned* bar, unsigned x, unsigned& nloc, unsigned& nx) {
    const unsigned G = gridDim.x * gridDim.y * gridDim.z;
    unsigned sum, cnt, mine, sp = 0u;
    for (;;) {
        sum = 0u; cnt = 0u; mine = 0u;
#pragma unroll
        for (unsigned j = 0; j < 16; ++j) { const unsigned c = xb_ld(&bar[XB_XCNT(j)]); sum += c; cnt += (c > 0u) ? 1u : 0u; mine = (j == x) ? c : mine; }
        if (sum == G) break;
        __builtin_amdgcn_s_sleep(1);
        if ((++sp & 255u) == 0u) { if (xb_ld(&bar[XB_TMO])) break; if (sp > XB_SPIN_CAP) { atomicAdd(&bar[XB_TMO], 1u); break; } }
    }
    nloc = mine > 0u ? mine : 1u; nx = cnt > 0u ? cnt : 1u;
}

__device__ __forceinline__ void xcd_barrier(const XcdBarrier& b) {
    asm volatile("s_waitcnt vmcnt(0)" ::: "memory");
    __syncthreads();
    if (threadIdx.x == 0) {
        unsigned* bar = b.bar;
        __builtin_amdgcn_s_waitcnt(0);
        unsigned nloc = b.st[0], nx = b.st[1];
        if (nloc == 0u) { xcd_barrier_complete(bar, b.x, nloc, nx); b.st[0] = nloc; b.st[1] = nx; }
        const unsigned old = xb_add(&bar[XB_XSUB(b.x)], 1u);
        const unsigned gen = old / nloc;
        if (old + 1u == (gen + 1u) * nloc) {
            __builtin_amdgcn_fence(__ATOMIC_RELEASE, "agent");
            asm volatile("s_waitcnt vmcnt(0)" ::: "memory");
            const unsigned og = xb_add(&bar[XB_TOP], 1u);
            const unsigned tg = og / nx;
            if (og + 1u == (tg + 1u) * nx) xb_add(&bar[XB_TOPGEN], 1u);
            else XB_SPIN(xb_ld(&bar[XB_TOPGEN]) == tg, bar);
            __builtin_amdgcn_fence(__ATOMIC_ACQUIRE, "agent");
            xb_add(&bar[XB_XGEN(b.x)], 1u);
            asm volatile("s_waitcnt vmcnt(0)" ::: "memory");
        } else {
            XB_SPIN(xb_ld(&bar[XB_XGEN(b.x)]) == gen, bar);
            __builtin_amdgcn_fence(__ATOMIC_ACQUIRE, "agent");
            asm volatile("s_waitcnt vmcnt(0)" ::: "memory");
        }
    }
    __syncthreads();
}


#define PHASE_IDS() int tid_ = threadIdx.x; asm volatile("" : "+v"(tid_)); const int tid = tid_, lane = tid & 63, wid = __builtin_amdgcn_readfirstlane(tid >> 6); (void)lane; (void)wid
struct Frame {
    LAS unsigned char* lds; volatile LAS unsigned* MISC; gu32* ctl;
    int vcu, G;
    const float *x, *p, *w_in, *a_ln_g, *a_ln_b, *a_w_s, *a_b_s, *lq1, *lk1, *lq2, *lk2, *subg, *w_a, *w_b, *w_out, *w_ple, *w_pg, *ln_g, *ln_b; const int* pos;
    float* out;
    bf16 *W1t, *WAt, *WBt, *WOt, *WPLt, *WSB, *PB, *XB, *SEG0, *SEG1, *SEG2, *SEG3, *SEG4, *SEG5, *GA, *GB;
    float *cosT, *sinT; f32x2* stats;
};

__device__ __forceinline__ void p0_transpose_item(const float* W, int K, int N, bf16* WT, int dst_row0, int k0, int n0, LAS float* scr, int lane) {
#pragma unroll 8
    for (int i = 0; i < 32; ++i) { const int kk = 2 * i + (lane >> 5); scr[kk * 33 + (lane & 31)] = W[(size_t)(k0 + kk) * N + n0 + (lane & 31)]; }
    LDS_WAIT(); asm volatile("" ::: "memory");
    const int c = lane & 7;
#pragma unroll
    for (int j = 0; j < 4; ++j) { const int n = (lane >> 3) + 8 * j; const LAS float* s = scr + (8 * c) * 33 + n;
        v4u o; o.x = pk2(s[0 * 33], s[1 * 33]); o.y = pk2(s[2 * 33], s[3 * 33]); o.z = pk2(s[4 * 33], s[5 * 33]); o.w = pk2(s[6 * 33], s[7 * 33]);
        *(GAS v4u*)(WT + (size_t)(dst_row0 + n) * K + k0 + 8 * c) = o; }
    LDS_WAIT(); asm volatile("" ::: "memory");
}
__device__ __forceinline__ int w1_dst_row(int n0) {
    const int seg = n0 >> 10, cq = n0 & 1023;
    if (seg != 3 && seg != 4) return n0;
    const int h = cq >> 7, mp = (cq >> 6) & 1, half = (cq >> 5) & 1, tile = h >> 1, mm = (h & 1) * 2 + mp;
    return seg * 1024 + tile * 256 + half * 128 + mm * 32;
}
__device__ __forceinline__ void p0_prologue(Frame& F) {
    PHASE_IDS();
    LAS float* scr = (LAS float*)(F.lds + RING_OFF + wid * 16384);
    const int gw = F.vcu * NWAVES + wid, NGW = F.G * NWAVES;
    constexpr int I_IN = (DM / 64) * (INW / 32), I_SQ = (DM / 64) * (DM / 32), I_PL = (PLE / 64) * (DM / 32);
    constexpr int NITEMS = I_IN + 4 * I_SQ + I_PL;
    for (int it = gw; it < NITEMS; it += NGW) {
        int r = it;
        if (r < I_IN) { const int kb = r / (INW / 32), nb = r % (INW / 32); p0_transpose_item(F.w_in, DM, INW, F.W1t, w1_dst_row(nb * 32), kb * 64, nb * 32, scr, lane); continue; } r -= I_IN;
        const int kb = r / 32 % 16, nb = r % 32;
        if (r < I_SQ) { p0_transpose_item(F.w_pg, DM, DM, F.W1t, INW + nb * 32, kb * 64, nb * 32, scr, lane); continue; } r -= I_SQ;
        if (r < I_SQ) { p0_transpose_item(F.w_a, DM, DM, F.WAt, nb * 32, kb * 64, nb * 32, scr, lane); continue; } r -= I_SQ;
        if (r < I_SQ) { p0_transpose_item(F.w_b, DM, DM, F.WBt, nb * 32, kb * 64, nb * 32, scr, lane); continue; } r -= I_SQ;
        if (r < I_SQ) { p0_transpose_item(F.w_out, DM, DM, F.WOt, nb * 32, kb * 64, nb * 32, scr, lane); continue; } r -= I_SQ;
        { const int kb2 = r / 32, nb2 = r % 32; p0_transpose_item(F.w_ple, PLE, DM, F.WPLt, nb2 * 32, kb2 * 64, nb2 * 32, scr, lane); }
    }
    const int gt = F.vcu * (NWAVES * 64) + tid, NGT = F.G * NWAVES * 64;
    for (int i = gt; i < M * DM / 8; i += NGT) { const GAS f32x4* s = (const GAS f32x4*)F.x + 2 * (size_t)i; const f32x4 a = s[0], b = s[1];
        v4u o; o.x = pk2(a[0], a[1]); o.y = pk2(a[2], a[3]); o.z = pk2(b[0], b[1]); o.w = pk2(b[2], b[3]); ((GAS v4u*)F.XB)[i] = o; }
    for (int i = gt; i < M * PLE / 8; i += NGT) { const GAS f32x4* s = (const GAS f32x4*)F.p + 2 * (size_t)i; const f32x4 a = s[0], b = s[1];
        v4u o; o.x = pk2(a[0], a[1]); o.y = pk2(a[2], a[3]); o.z = pk2(b[0], b[1]); o.w = pk2(b[2], b[3]); ((GAS v4u*)F.PB)[i] = o; }
    for (int i = gt; i < M * 32; i += NGT) { const float ang = (float)F.pos[i >> 5] * INVF[i & 31]; F.cosT[i] = cosf(ang); F.sinT[i] = sinf(ang); }
    for (int i = gt; i < 8 * 128 * 128; i += NGT) { const int t = (i >> 7) & 127, s = i & 127; F.WSB[i] = (bf16)f2bf(s <= t ? F.a_w_s[i] : 0.f); }
}

constexpr int BA_VN = 0, BA_SA = 32768, BA_SA_STRIDE = 132, BA_MU = BA_SA + 128 * BA_SA_STRIDE * 4;
static_assert(BA_MU + 1024 <= RING_BYTES, "branch A LDS");
__device__ __forceinline__ void brancha_phase(Frame& F, char* lds) {
    PHASE_IDS();
    const int r32 = lane & 31, hi = lane >> 5;
    const int tb = wid & 3, ch = wid >> 2;
    float* SA = (float*)(lds + BA_SA); f32x2* MU = (f32x2*)(lds + BA_MU);
    const int vb0 = (int)(uintptr_t)(lds + BA_VN) + att::v_rd_base(lane);
    const int rr = tid >> 4, c8 = (tid & 15) * 8;
    for (int chunk = F.vcu; chunk < M / 128; chunk += F.G) {
        const int tok0 = chunk * 128;
        if (tid < 128) { float a = 0.f, b = 0.f; const f32x2* sp = F.stats + (size_t)(tok0 + tid) * 16;
#pragma unroll
            for (int q = 0; q < 16; ++q) { const f32x2 v = sp[q]; a += v.x; b += v.y; }
            const float mean = a * (1.f / 1024.f), var = b * (1.f / 1024.f) - mean * mean; MU[tid] = (f32x2){mean, rsqrtf(var + LN_EPS)}; }
        __syncthreads();
        for (int g = 0; g < 8; ++g) {
            const size_t cb = (size_t)tok0 * DM + g * 128 + c8;
            const f32x4 g0 = *(const f32x4*)(F.a_ln_g + g * 128 + c8), g1 = *(const f32x4*)(F.a_ln_g + g * 128 + c8 + 4);
            const f32x4 b0 = *(const f32x4*)(F.a_ln_b + g * 128 + c8), b1 = *(const f32x4*)(F.a_ln_b + g * 128 + c8 + 4);
            v4u uav[4], zav[4];
#pragma unroll
            for (int i = 0; i < 4; ++i) { const int row = rr + 32 * i; const v4u w = *(const v4u*)(F.SEG1 + cb + (size_t)row * DM);
                uav[i] = *(const v4u*)(F.SEG0 + cb + (size_t)row * DM); zav[i] = *(const v4u*)(F.SEG2 + cb + (size_t)row * DM);
                const f32x2 ms = MU[row];
                const f32x4 v0 = ((f32x4){bflo(w.x), bfhi(w.x), bflo(w.y), bfhi(w.y)} - ms.x) * ms.y * g0 + b0;
                const f32x4 v1 = ((f32x4){bflo(w.z), bfhi(w.z), bflo(w.w), bfhi(w.w)} - ms.x) * ms.y * g1 + b1;
                v4u o; o.x = pk2(v0[0], v0[1]); o.y = pk2(v0[2], v0[3]); o.z = pk2(v1[0], v1[1]); o.w = pk2(v1[2], v1[3]);
                *(v4u*)(lds + BA_VN + (row >> 6) * 16384 + att::v_st(row & 63, c8)) = o; }
            __syncthreads();
            f32x16 o2[2]; o2[0] = f32x16{}; o2[1] = f32x16{};
            const bf16* wrow = F.WSB + ((size_t)g * 128 + 32 * tb + r32) * 128 + 8 * hi;
            const int nks = 2 * tb + 2;
            for (int k16 = 0; k16 < nks; ++k16) {
                const bf16x8 af = *(const bf16x8*)(wrow + 16 * k16);
                const int base = vb0 + (k16 >> 2) * 16384 + (k16 & 3) * 4096 + ch * 1024;
                s16x4 l0, h0, l1, h1;
                asm volatile("ds_read_b64_tr_b16 %0, %1" : "=&v"(l0) : "v"(base) : "memory");
                asm volatile("ds_read_b64_tr_b16 %0, %1 offset:2048" : "=&v"(h0) : "v"(base) : "memory");
                asm volatile("ds_read_b64_tr_b16 %0, %1 offset:512" : "=&v"(l1) : "v"(base) : "memory");
                asm volatile("ds_read_b64_tr_b16 %0, %1 offset:2560" : "=&v"(h1) : "v"(base) : "memory");
                asm volatile("s_waitcnt lgkmcnt(0)" ::: "memory"); __builtin_amdgcn_sched_barrier(0);
                o2[0] = __builtin_amdgcn_mfma_f32_32x32x16_bf16(af, (bf16x8){l0[0], l0[1], l0[2], l0[3], h0[0], h0[1], h0[2], h0[3]}, o2[0], 0, 0, 0);
                o2[1] = __builtin_amdgcn_mfma_f32_32x32x16_bf16(af, (bf16x8){l1[0], l1[1], l1[2], l1[3], h1[0], h1[1], h1[2], h1[3]}, o2[1], 0, 0, 0);
            }
#pragma unroll
            for (int r = 0; r < 16; ++r) { const int t = 32 * tb + att::crow(r, hi);
                SA[t * BA_SA_STRIDE + 64 * ch + r32] = o2[0][r]; SA[t * BA_SA_STRIDE + 64 * ch + 32 + r32] = o2[1][r]; }
            __syncthreads();
#pragma unroll
            for (int i = 0; i < 4; ++i) { const int row = rr + 32 * i; const float bs = F.a_b_s[g * 128 + row];
                const f32x4 s0 = *(const f32x4*)(SA + row * BA_SA_STRIDE + c8) + bs, s1 = *(const f32x4*)(SA + row * BA_SA_STRIDE + c8 + 4) + bs;
                const v4u ua = uav[i], za = zav[i]; v4u o;
                o.x = pk2(bflo(ua.x) * s0[0] * bflo(za.x), bfhi(ua.x) * s0[1] * bfhi(za.x)); o.y = pk2(bflo(ua.y) * s0[2] * bflo(za.y), bfhi(ua.y) * s0[3] * bfhi(za.y));
                o.z = pk2(bflo(ua.z) * s1[0] * bflo(za.z), bfhi(ua.z) * s1[1] * bfhi(za.z)); o.w = pk2(bflo(ua.w) * s1[2] * bflo(za.w), bfhi(ua.w) * s1[3] * bfhi(za.w));
                *(v4u*)(F.SEG0 + cb + (size_t)row * DM) = o; }
            __syncthreads();
        }
    }
}

__device__ __forceinline__ void ln_final_phase(Frame& F) {
    PHASE_IDS();
    const int gw = F.vcu * NWAVES + wid, NGW = F.G * NWAVES;
    f32x4 gv[4], bv[4];
#pragma unroll
    for (int j = 0; j < 4; ++j) { gv[j] = *(const f32x4*)(F.ln_g + 256 * j + 4 * lane); bv[j] = *(const f32x4*)(F.ln_b + 256 * j + 4 * lane); }
    for (int row = gw; row < M; row += NGW) {
        GAS f32x4* yr = (GAS f32x4*)(F.out + (size_t)row * DM) + lane;
        f32x4 v[4];
#pragma unroll
        for (int j = 0; j < 4; ++j) v[j] = yr[64 * j];
        float a = 0.f, b = 0.f;
        if (lane < 16) { const f32x2 s = F.stats[(size_t)row * 16 + lane]; a = s.x; b = s.y; }
        a = wave_sum(a); b = wave_sum(b);
        const float mean = a * (1.f / 1024.f), var = b * (1.f / 1024.f) - mean * mean, rstd = rsqrtf(var + LN_EPS);
#pragma unroll
        for (int j = 0; j < 4; ++j) yr[64 * j] = (v[j] - mean) * rstd * gv[j] + bv[j];
    }
}

struct Args { const void* in[20]; float* out; unsigned char* ws; int ph_lo, ph_hi; };
__global__ void __launch_bounds__(NWAVES * 64, 2) mega_fwd(Args args) {
    extern __shared__ __attribute__((aligned(16))) unsigned char lds[];
    Frame F;
    F.lds = (LAS unsigned char*)lds; F.MISC = (volatile LAS unsigned*)(F.lds + MISC_OFF);
    F.G = gridDim.x; { const int bx = blockIdx.x; F.vcu = (F.G % 8 == 0) ? (bx % 8) * (F.G / 8) + bx / 8 : bx; }
    unsigned char* ws = args.ws;
    F.ctl = (gu32*)(ws + WS_CTL);
    F.x = (const float*)args.in[0]; F.p = (const float*)args.in[1]; F.pos = (const int*)args.in[2]; F.w_in = (const float*)args.in[3];
    F.a_ln_g = (const float*)args.in[4]; F.a_ln_b = (const float*)args.in[5]; F.a_w_s = (const float*)args.in[6]; F.a_b_s = (const float*)args.in[7];
    F.lq1 = (const float*)args.in[8]; F.lk1 = (const float*)args.in[9]; F.lq2 = (const float*)args.in[10]; F.lk2 = (const float*)args.in[11];
    F.subg = (const float*)args.in[12]; F.w_a = (const float*)args.in[13]; F.w_b = (const float*)args.in[14]; F.w_out = (const float*)args.in[15];
    F.w_ple = (const float*)args.in[16]; F.w_pg = (const float*)args.in[17]; F.ln_g = (const float*)args.in[18]; F.ln_b = (const float*)args.in[19];
    F.out = args.out;
    F.W1t = (bf16*)(ws + WS_W1T); F.WAt = (bf16*)(ws + WS_WAT); F.WBt = (bf16*)(ws + WS_WBT); F.WOt = (bf16*)(ws + WS_WOT); F.WPLt = (bf16*)(ws + WS_WPLT); F.WSB = (bf16*)(ws + WS_WSB);
    F.PB = (bf16*)(ws + WS_PB); F.XB = (bf16*)(ws + WS_XB);
    F.SEG0 = (bf16*)(ws + WS_SEG0); F.SEG1 = (bf16*)(ws + WS_SEG1); F.SEG2 = (bf16*)(ws + WS_SEG2); F.SEG3 = (bf16*)(ws + WS_SEG3); F.SEG4 = (bf16*)(ws + WS_SEG4); F.SEG5 = (bf16*)(ws + WS_SEG5);
    F.GA = (bf16*)args.out; F.GB = F.GA + (size_t)M * DM;
    F.cosT = (float*)(ws + WS_COS); F.sinT = (float*)(ws + WS_SIN); F.stats = (f32x2*)(ws + WS_STATS);
    for (int u = threadIdx.x; u < (LDS_BYTES - LDSCTL_OFF) / 4; u += NWAVES * 64) ((LAS unsigned*)(F.lds + LDSCTL_OFF))[u] = 0u;
    __syncthreads();
    XcdBarrier bar; bar.bar = (unsigned*)(F.ctl + CW_BAR); bar.x = 0; bar.st = nullptr;
    if (N_LAUNCHES == 1) bar = xcd_barrier_post((unsigned*)(F.ctl + CW_BAR), F.MISC + 8);
    const int lo = args.ph_lo, hi = args.ph_hi;
#define IN(k) (lo <= (k) && (k) < hi)
#define SEAM(k) do { if (IN(k) && IN((k) + 1)) xcd_barrier(bar); } while (0)

    if (IN(0)) { p0_prologue(F); } SEAM(0);
    if (IN(1)) {
        pg8::Gemm g{F.XB, F.W1t, M, 3072, DM}; pg8::StaticOrder S; S.init(M, 3072, F.G, (int)blockIdx.x);
        pg8::EpiG1 E{0, F.SEG0, F.SEG1, F.SEG2, nullptr, nullptr, nullptr, nullptr, F.cosT, F.sinT, F.stats};
        pg8::gemm_phase<pg8::EpiG1, pg8::StaticOrder, true, true>(F.lds + RING_OFF, g, S, E);
    } SEAM(1);
    if (IN(2)) { brancha_phase(F, (char*)lds + RING_OFF); } SEAM(2);
    if (IN(3)) {
#if defined(MK_P3_SPLIT)
        { pg8::Gemm g{F.XB, F.W1t + (size_t)3072 * DM, M, 3072, DM}; pg8::StaticOrder S; S.init(M, 3072, F.G, (int)blockIdx.x);
          pg8::EpiG1 E{3, F.SEG1, F.SEG2, F.SEG3, nullptr, nullptr, nullptr, nullptr, F.cosT, F.sinT, F.stats};
          pg8::gemm_phase<pg8::EpiG1, pg8::StaticOrder, true, true>(F.lds + RING_OFF, g, S, E); }
        { pg8::Gemm g{F.XB, F.W1t + (size_t)6144 * DM, M, 4096, DM}; pg8::StaticOrder S; S.init(M, 4096, F.G, (int)blockIdx.x);
          pg8::EpiG1 E{6, F.SEG4, F.GA, F.GB, F.SEG5, nullptr, nullptr, nullptr, F.cosT, F.sinT, F.stats};
          pg8::gemm_phase<pg8::EpiG1, pg8::StaticOrder, true, true>(F.lds + RING_OFF, g, S, E); }
#else
        pg8::Gemm g{F.XB, F.W1t + (size_t)3072 * DM, M, N1 - 3072, DM}; pg8::StaticOrder S; S.init(M, N1 - 3072, F.G, (int)blockIdx.x);
        pg8::EpiG1 E{3, F.SEG1, F.SEG2, F.SEG3, F.SEG4, F.GA, F.GB, F.SEG5, F.cosT, F.sinT, F.stats};
        pg8::gemm_phase<pg8::EpiG1, pg8::StaticOrder, true, true>(F.lds + RING_OFF, g, S, E);
#endif
    } SEAM(3);
    if (IN(4)) {
        PHASE_IDS();
        const float lam = expf(wave_sum(F.lq1[lane] * F.lk1[lane])) - expf(wave_sum(F.lq2[lane] * F.lk2[lane])) + LAM_INIT;
        att::attn_phase((char*)lds + RING_OFF, F.SEG1, F.SEG2, F.SEG3, F.SEG4, F.vcu, F.G, lam, F.subg);
    } SEAM(4);
    if (IN(5)) {
        { pg8::Gemm g{F.SEG0, F.WAt, M, DM, DM}; pg8::StaticOrder S; S.init(M, DM, F.G, (int)blockIdx.x);
          pg8::EpiGate E{F.GA, nullptr, F.SEG1};
          pg8::gemm_phase<pg8::EpiGate, pg8::StaticOrder, true, true>(F.lds + RING_OFF, g, S, E); }
        { pg8::Gemm g{F.SEG4, F.WBt, M, DM, DM}; pg8::StaticOrder S; S.init(M, DM, F.G, (int)blockIdx.x);
          pg8::EpiGate E{F.GB, F.SEG1, F.SEG1};
          pg8::gemm_phase<pg8::EpiGate, pg8::StaticOrder, true, true>(F.lds + RING_OFF, g, S, E); }
    } SEAM(5);
    if (IN(6)) {
        { pg8::Gemm g{F.PB, F.WPLt, M, DM, PLE}; pg8::StaticOrder S; S.init(M, DM, F.G, (int)blockIdx.x);
          pg8::EpiRes E{F.x, F.SEG5, F.out, ALPHA};
          pg8::gemm_phase<pg8::EpiRes, pg8::StaticOrder, true, true>(F.lds + RING_OFF, g, S, E); }
        { pg8::Gemm g{F.SEG1, F.WOt, M, DM, DM}; pg8::StaticOrder S; S.init(M, DM, F.G, (int)blockIdx.x);
          pg8::EpiY E{F.out, F.stats};
          pg8::gemm_phase<pg8::EpiY, pg8::StaticOrder, true, true>(F.lds + RING_OFF, g, S, E); }
    } SEAM(6);
    if (IN(7)) { ln_final_phase(F); }
#undef IN
#undef SEAM
}

#if MK_N_LAUNCHES == 8 && defined(MK_NAIVE_MASK)
static void naive_phase(int ph, void* const* d_in, void* d_out, void* d_ws, hipStream_t stream) {
    using namespace nv;
    const float* x = (const float*)d_in[0]; const float* p = (const float*)d_in[1];
    const float* w_in = (const float*)d_in[3]; const float* a_ln_g = (const float*)d_in[4]; const float* a_ln_b = (const float*)d_in[5];
    const float* a_w_s = (const float*)d_in[6]; const float* a_b_s = (const float*)d_in[7];
    const float* lq1 = (const float*)d_in[8]; const float* lk1 = (const float*)d_in[9]; const float* lq2 = (const float*)d_in[10]; const float* lk2 = (const float*)d_in[11];
    const float* subg = (const float*)d_in[12]; const float* w_a = (const float*)d_in[13]; const float* w_b = (const float*)d_in[14];
    const float* w_out = (const float*)d_in[15]; const float* w_ple = (const float*)d_in[16]; const float* w_pg = (const float*)d_in[17];
    const float* ln_g = (const float*)d_in[18]; const float* ln_b = (const float*)d_in[19];
    unsigned char* ws = (unsigned char*)d_ws; float* out = (float*)d_out;
    float* cosT = (float*)(ws + WS_COS); float* sinT = (float*)(ws + WS_SIN); float2* stats = (float2*)(ws + WS_STATS);
    nv::bf16_t* SEG0 = (nv::bf16_t*)(ws + WS_SEG0); nv::bf16_t* SEG1 = (nv::bf16_t*)(ws + WS_SEG1); nv::bf16_t* SEG2 = (nv::bf16_t*)(ws + WS_SEG2);
    nv::bf16_t* SEG3 = (nv::bf16_t*)(ws + WS_SEG3); nv::bf16_t* SEG4 = (nv::bf16_t*)(ws + WS_SEG4); nv::bf16_t* SEG5 = (nv::bf16_t*)(ws + WS_SEG5);
    nv::bf16_t* GA = (nv::bf16_t*)d_out; nv::bf16_t* GB = GA + (size_t)nv::M * 1024;
    const dim3 g1(16, nv::M / 64);
    auto seg = [&](int s, int act, nv::bf16_t* dst, float scale) {
        NEpi e{}; e.act = act; e.scale = scale; e.cosT = cosT; e.sinT = sinT; e.outb = dst;
        const float* B = s < 9 ? w_in + s * 1024 : w_pg; const int ldb = s < 9 ? nv::INW : 1024;
        k_ngemm<0><<<g1, 256, 0, stream>>>(x, nv::DM, B, ldb, nv::DM, e);
    };
    switch (ph) {
    case 1: seg(0, 1, SEG0, 1.f); seg(1, 1, SEG1, 1.f); seg(2, 2, SEG2, 1.f); k_stats<<<nv::M / 4, 256, 0, stream>>>(SEG1, stats); break;
    case 2: k_brancha<<<(nv::M / 128) * 8, 128, 0, stream>>>(SEG0, SEG1, SEG2, stats, a_ln_g, a_ln_b, a_w_s, a_b_s); break;
    case 3: seg(3, 4, SEG1, 0.125f); seg(4, 4, SEG2, 1.f); seg(5, 0, SEG3, 1.f); seg(6, 2, SEG4, 1.f); seg(7, 3, GA, 1.f); seg(8, 3, GB, 1.f); seg(9, 3, SEG5, 1.f); break;
    case 4: k_attn<<<nv::M * 8 / 4, 256, 0, stream>>>(SEG1, SEG2, SEG3, SEG4, lq1, lk1, lq2, lk2, subg); break;
    case 5: { NEpi e{}; e.gate = GA; e.outb = SEG1; k_ngemm<1><<<g1, 256, 0, stream>>>(SEG0, 1024, w_a, 1024, 1024, e); }
            { NEpi e{}; e.gate = GB; e.addb = SEG1; e.outb = SEG1; k_ngemm<1><<<g1, 256, 0, stream>>>(SEG4, 1024, w_b, 1024, 1024, e); } break;
    case 6: { NEpi e{}; e.gate = SEG5; e.addf = x; e.addf_scale = nv::ALPHA; e.outf = out; k_ngemm<0><<<g1, 256, 0, stream>>>(p, nv::PLE, w_ple, 1024, nv::PLE, e); }
            { NEpi e{}; e.addf = out; e.addf_scale = 1.f; e.outf = out; k_ngemm<1><<<g1, 256, 0, stream>>>(SEG1, 1024, w_out, 1024, 1024, e); } break;
    case 7: k_ln_final<<<nv::M / 4, 256, 0, stream>>>(out, ln_g, ln_b); break;
    default: if (ph >= 100) { const int fx = ph - 100;
                 if (fx & 1) seg(3, 4, SEG1, 0.125f); if (fx & 2) seg(4, 4, SEG2, 1.f); if (fx & 4) seg(5, 0, SEG3, 1.f); if (fx & 8) seg(6, 2, SEG4, 1.f);
                 if (fx & 16) seg(7, 3, GA, 1.f); if (fx & 32) seg(8, 3, GB, 1.f); if (fx & 64) seg(9, 3, SEG5, 1.f); }
             break;
    }
}
#endif
#if defined(MK_RAW_ACT)
__global__ void k_act_inplace(unsigned short* b, int act) {
    for (size_t i = (size_t)blockIdx.x * blockDim.x + threadIdx.x; i < (size_t)M * DM; i += (size_t)gridDim.x * blockDim.x) {
        const float v = __uint_as_float(((unsigned)b[i]) << 16); const float sg = 1.f / (1.f + expf(-v)); b[i] = (unsigned short)f2bf(act == 2 ? v * sg : sg); }
}
#endif
extern "C" void kernel_launch(void* const* d_in, const int* in_sizes, int n_in, void* d_out, int out_size, void* d_ws, size_t ws_size, hipStream_t stream) {
    static int grid = 0;
    if (grid == 0) {
        if (n_in != 20 || in_sizes[0] != M * DM || out_size != M * DM || ws_size < WS_END) {
            fprintf(stderr, "kernel_launch: built for 20 inputs, x/out of %d floats, >= %zu bytes of workspace; got n_in %d, in0 %d, out %d, ws %zu; nothing launched\n", M * DM, (size_t)WS_END, n_in, n_in > 0 ? in_sizes[0] : -1, out_size, ws_size);
            grid = -1; return; }
        int dev = 0, cus = 0, per_cu = 0;
        if (hipGetDevice(&dev) != hipSuccess || hipDeviceGetAttribute(&cus, hipDeviceAttributeMultiprocessorCount, dev) != hipSuccess) { fprintf(stderr, "kernel_launch: device query failed\n"); grid = -1; return; }
        if (hipFuncSetAttribute((const void*)mega_fwd, hipFuncAttributeMaxDynamicSharedMemorySize, LDS_BYTES) != hipSuccess) { fprintf(stderr, "kernel_launch: hipFuncSetAttribute failed\n"); grid = -1; return; }
        if (hipOccupancyMaxActiveBlocksPerMultiprocessor(&per_cu, (const void*)mega_fwd, NWAVES * 64, LDS_BYTES) != hipSuccess || per_cu < 1) {
            fprintf(stderr, "kernel_launch: occupancy query reports %d workgroups per CU; nothing launched\n", per_cu); (void)hipGetLastError(); grid = -1; return; }
        (void)hipGetLastError();
        grid = cus;
    }
    if (grid < 0) return;
    if (N_LAUNCHES == 1) { if (hipMemsetAsync((char*)d_ws + WS_CTL, 0, CTL_ZERO_BYTES, stream) != hipSuccess) { fprintf(stderr, "kernel_launch: memset failed\n"); return; } }
    Args a{};
    for (int i = 0; i < 20; ++i) a.in[i] = d_in[i];
    a.out = (float*)d_out; a.ws = (unsigned char*)d_ws;
    for (int li = 0; li < N_LAUNCHES; ++li) {
        a.ph_lo = (N_LAUNCHES == 1) ? 0 : li; a.ph_hi = (N_LAUNCHES == 1) ? NPHASE : li + 1;
#if MK_N_LAUNCHES == 8 && defined(MK_NAIVE_MASK)
        if ((MK_NAIVE_MASK >> li) & 1) { naive_phase(li, d_in, d_out, d_ws, stream); continue; }
#endif
        hipLaunchKernelGGL(mega_fwd, dim3(grid), dim3(NWAVES * 64), LDS_BYTES, stream, a);
#if defined(MK_RAW_ACT)
        if (li == 3) { unsigned char* w_ = (unsigned char*)d_ws;
            k_act_inplace<<<4096, 256, 0, stream>>>((unsigned short*)(w_ + WS_SEG4), 2); k_act_inplace<<<4096, 256, 0, stream>>>((unsigned short*)d_out, 3);
            k_act_inplace<<<4096, 256, 0, stream>>>((unsigned short*)d_out + (size_t)M * DM, 3); k_act_inplace<<<4096, 256, 0, stream>>>((unsigned short*)(w_ + WS_SEG5), 3); }
#endif
#if defined(MK_P3_TWICE)
        if (li == 3) hipLaunchKernelGGL(mega_fwd, dim3(grid), dim3(NWAVES * 64), LDS_BYTES, stream, a);
#endif
#if MK_N_LAUNCHES == 8 && defined(MK_NAIVE_MASK) && defined(MK_P3_FIX)
        if (li == 3) naive_phase(100 + MK_P3_FIX, d_in, d_out, d_ws, stream);
#endif
        const hipError_t le = hipPeekAtLastError();
        if (le != hipSuccess) { fprintf(stderr, "kernel_launch: launch %d failed: %s\n", li, hipGetErrorName(le)); break; }
    }
}
```
